# Optimizing an MI355X kernel written in HIP

```python
import math
import jax, jax.numpy as jnp
from jax import lax
import numpy as np

D_MODEL = 1024
BATCH = 2
SEQ = 8192
DEPTH = 2

F32 = jnp.float32
NEG_BIG = -1e30
LOG_TINY = 1e-30
A_HEADS = 8
A_HEAD_DIM = 64
IDX_HEADS = 8
IDX_DIM = 64
IDX_TOPK = 256
Q_BLOCK = 128
B_HEADS = 4
B_KEY_DIM = 128
B_VAL_DIM = 128
B_CHUNK = 64
C_Q_HEADS = 8
C_KV_HEADS = 2
C_HEAD_DIM = 64
WINDOW = 128
BRANCH_WIDTH = 512
N_BRANCHES = 3
N_BUCKETS = 32
MAX_DISTANCE = 128
MEM_LEN = 256
MEM_HEADS = 4
MEM_HEAD_DIM = D_MODEL // MEM_HEADS
N_GROUPS = 4
EXPERTS_PER_GROUP = 8
N_EXPERTS = N_GROUPS * EXPERTS_PER_GROUP
EXPERT_TOPK = 2
D_EXPERT = 512
MOE_BLOCK = 128
DEEPNORM_ALPHA = (2 * DEPTH) ** 0.25
DEEPNORM_BETA = (8 * DEPTH) ** -0.25
LN_EPS = 1e-5
RMS_EPS = 1e-6

SPLITS = (
    A_HEADS * A_HEAD_DIM,
    A_HEADS * A_HEAD_DIM,
    A_HEADS * A_HEAD_DIM,
    IDX_HEADS * IDX_DIM,
    IDX_DIM,
    IDX_HEADS,
    B_HEADS * B_KEY_DIM,
    B_HEADS * B_KEY_DIM,
    B_HEADS * B_VAL_DIM,
    B_HEADS * B_VAL_DIM,
    C_Q_HEADS * C_HEAD_DIM,
    C_KV_HEADS * C_HEAD_DIM,
    C_KV_HEADS * C_HEAD_DIM,
    N_BRANCHES * D_MODEL,
)
IN_WIDTH = sum(SPLITS)

kernel_name = 'hybrid_dsa_hgrn2_swa_hmoe_deepnorm'


def layer_norm(x, g, b):
    xf = x.astype(F32)
    mu = jnp.mean(xf, axis=-1, keepdims=True)
    var = jnp.mean(jnp.square(xf - mu), axis=-1, keepdims=True)
    return ((xf - mu) * lax.rsqrt(var + LN_EPS) * g.astype(F32) + b.astype(F32)).astype(x.dtype)


def t5_bucket(dist):
    exact = N_BUCKETS // 2
    d = dist.astype(F32)
    large = exact + (jnp.log(jnp.maximum(d, float(exact)) / exact) / math.log(MAX_DISTANCE / exact)
                     * (N_BUCKETS - exact)).astype(jnp.int32)
    large = jnp.minimum(large, N_BUCKETS - 1)
    return jnp.where(dist < exact, dist, large)


def dsa_attention(q, k, v, iq, ik, iw, bias_table):
    bsz, s = q.shape[0], q.shape[1]
    nb = s // Q_BLOCK
    topk = min(IDX_TOPK, s // 4)
    spos = jnp.arange(s)
    iq = iq * (IDX_DIM ** -0.5)
    iw = iw * (IDX_HEADS ** -0.5)
    scale = A_HEAD_DIM ** -0.5
    gather = jax.vmap(lambda a, i: a[i])

    def blocks(a):
        return a.reshape(bsz, nb, Q_BLOCK, *a.shape[2:]).swapaxes(0, 1)

    def one_block(args):
        qb, iqb, iwb, n = args
        tpos = n * Q_BLOCK + jnp.arange(Q_BLOCK)
        score = jnp.einsum('bths,bth->bts', jax.nn.relu(jnp.einsum('bthd,bsd->bths', iqb, ik)), iwb).astype(F32)
        score = jnp.where((spos[None, :] <= tpos[:, None])[None], score, NEG_BIG)
        _, idx = lax.top_k(score, topk)
        flat = idx.reshape(bsz, Q_BLOCK * topk)
        ks = gather(k, flat).reshape(bsz, Q_BLOCK, topk, A_HEADS, A_HEAD_DIM)
        vs = gather(v, flat).reshape(bsz, Q_BLOCK, topk, A_HEADS, A_HEAD_DIM)
        dist = tpos[None, :, None] - idx
        bias = bias_table[t5_bucket(jnp.maximum(dist, 0))]
        logits = jnp.einsum('bthd,btkhd->btkh', qb, ks).astype(F32) * scale + bias.astype(F32)
        logits = jnp.where((dist >= 0)[..., None], logits, NEG_BIG)
        p = jax.nn.softmax(logits, axis=2).astype(v.dtype)
        return jnp.einsum('btkh,btkhd->bthd', p, vs)

    out = lax.map(one_block, (blocks(q), blocks(iq), blocks(iw), jnp.arange(nb)))
    return out.swapaxes(0, 1).reshape(bsz, s, A_HEADS * A_HEAD_DIM)


def hgrn2_scan(q, logf, v):
    bsz, s, h, dk = q.shape
    dv = v.shape[-1]
    nc = s // B_CHUNK
    k = -jnp.expm1(logf)

    def to_chunks(a):
        return a.reshape(bsz, nc, B_CHUNK, h, a.shape[-1]).transpose(1, 0, 3, 2, 4)

    causal = jnp.tril(jnp.ones((B_CHUNK, B_CHUNK), dtype=bool))

    def step(state, inp):
        qc, gc, kc, vc = inp
        a = jnp.cumsum(gc, axis=2)
        diff = a[:, :, :, None, :] - a[:, :, None, :, :]
        decay = jnp.exp(jnp.where(causal[:, :, None], diff, NEG_BIG))
        attn = jnp.einsum('bhtd,bhtsd,bhsd->bhts', qc, decay, kc)
        o = jnp.einsum('bhts,bhsv->bhtv', attn, vc) + jnp.einsum('bhtd,bhdv->bhtv', qc * jnp.exp(a), state)
        a_last = a[:, :, -1:, :]
        new_state = jnp.exp(a_last[:, :, 0, :])[..., None] * state + jnp.einsum(
            'bhsd,bhsv->bhdv', kc * jnp.exp(a_last - a), vc)
        return new_state, o

    init = jnp.zeros((bsz, h, dk, dv), F32)
    _, o = lax.scan(step, init, (to_chunks(q), to_chunks(logf), to_chunks(k), to_chunks(v)))
    return o.transpose(1, 0, 3, 2, 4).reshape(bsz, s, h, dv)


def hgrn2_branch(q, f, i, g, lb, norm_gain):
    bsz, s, _ = q.shape
    qh = jax.nn.silu(q.astype(F32)).reshape(bsz, s, B_HEADS, B_KEY_DIM)
    fz = f.astype(F32).reshape(bsz, s, B_HEADS, B_KEY_DIM)
    lbh = jnp.clip(lb.astype(F32), LOG_TINY, 1.0 - 1e-6).reshape(B_HEADS, B_KEY_DIM)
    logf = jnp.logaddexp(jnp.log(lbh), jnp.log1p(-lbh) + jax.nn.log_sigmoid(fz))
    vh = i.astype(F32).reshape(bsz, s, B_HEADS, B_VAL_DIM)
    o = hgrn2_scan(qh, logf, vh)
    o = o * lax.rsqrt(jnp.mean(jnp.square(o), axis=-1, keepdims=True) + RMS_EPS)
    o = o.reshape(bsz, s, B_HEADS * B_VAL_DIM) * norm_gain.astype(F32) * jax.nn.silu(g.astype(F32))
    return o.astype(q.dtype)


def swa_sink_attention(q, k, v, sinks, bias_table):
    bsz, s = q.shape[0], q.shape[1]
    nb = s // WINDOW
    grp = C_Q_HEADS // C_KV_HEADS
    qb = q.reshape(bsz, nb, WINDOW, C_KV_HEADS, grp, C_HEAD_DIM)

    def band(a):
        a = a.reshape(bsz, nb, WINDOW, C_KV_HEADS, C_HEAD_DIM)
        prev = jnp.concatenate([jnp.zeros_like(a[:, :1]), a[:, :-1]], axis=1)
        return jnp.concatenate([prev, a], axis=2)

    kb, vb = band(k), band(v)
    qi = jnp.arange(WINDOW)[:, None]
    kj = jnp.arange(2 * WINDOW)[None, :]
    dist = qi + WINDOW - kj
    kpos = (jnp.arange(nb)[:, None, None] - 1) * WINDOW + kj[None]
    mask = ((dist >= 0) & (dist < WINDOW))[None] & (kpos >= 0)
    bias = bias_table[t5_bucket(jnp.maximum(dist, 0))]
    bias = bias.reshape(WINDOW, 2 * WINDOW, C_KV_HEADS, grp).transpose(2, 3, 0, 1).astype(F32)
    logits = jnp.einsum('bnqhgd,bnkhd->bnhgqk', qb, kb).astype(F32) * (C_HEAD_DIM ** -0.5) + bias
    logits = jnp.where(mask[None, :, None, None], logits, NEG_BIG)
    sink = jnp.broadcast_to(sinks.astype(F32).reshape(C_KV_HEADS, grp, 1, 1), logits.shape[:-1] + (1,))
    p = jax.nn.softmax(jnp.concatenate([logits, sink], axis=-1), axis=-1)[..., :-1].astype(v.dtype)
    out = jnp.einsum('bnhgqk,bnkhd->bnqhgd', p, vb)
    return out.reshape(bsz, s, C_Q_HEADS * C_HEAD_DIM)


def hybrid_mixer(x, w_in, w_branch, w_out, lb, norm_gain, sinks, rel_bias):
    bsz, s, _ = x.shape
    proj = x @ w_in
    offsets = np.cumsum(SPLITS)[:-1].tolist()
    (a_q, a_k, a_v, i_q, i_k, i_w, b_q, b_f, b_i, b_g, c_q, c_k, c_v, gate) = jnp.split(proj, offsets, axis=-1)

    def heads(t, h):
        return t.reshape(bsz, s, h, -1)

    ya = dsa_attention(heads(a_q, A_HEADS), heads(a_k, A_HEADS), heads(a_v, A_HEADS),
                       heads(i_q, IDX_HEADS), i_k, i_w, rel_bias[:, :A_HEADS])
    yb = hgrn2_branch(b_q, b_f, b_i, b_g, lb, norm_gain)
    yc = swa_sink_attention(heads(c_q, C_Q_HEADS), heads(c_k, C_KV_HEADS), heads(c_v, C_KV_HEADS),
                            sinks, rel_bias[:, A_HEADS:])
    branches = jnp.stack([ya, yb, yc], axis=2)
    up = jnp.einsum('bsgc,gcd->bsgd', branches, w_branch)
    gates = jax.nn.sigmoid(gate.reshape(bsz, s, N_BRANCHES, D_MODEL))
    merged = jnp.einsum('bsgd,bsgd->bsd', gates, up)
    return merged @ w_out


def memory_cross_attention(x, mem, wq, wkv, wo):
    bsz, s, _ = x.shape
    m = mem.shape[1]
    q = (x @ wq).reshape(bsz, s, MEM_HEADS, MEM_HEAD_DIM)
    kv = (mem @ wkv).reshape(bsz, m, 2, MEM_HEADS, MEM_HEAD_DIM)
    logits = jnp.einsum('bshd,bmhd->bhsm', q, kv[:, :, 0]).astype(F32) * (MEM_HEAD_DIM ** -0.5)
    p = jax.nn.softmax(logits, axis=-1).astype(x.dtype)
    o = jnp.einsum('bhsm,bmhd->bshd', p, kv[:, :, 1]).reshape(bsz, s, D_MODEL)
    return o @ wo


def routed_expert_mlps(xf, expert, weight, w1, w3, w2):
    n_tok, d = xf.shape
    n_asg = expert.shape[0]
    tok = jnp.arange(n_asg) // EXPERT_TOPK
    order = jnp.argsort(expert)
    se, stok, sw = expert[order], tok[order], weight[order]
    counts = jnp.bincount(expert, length=N_EXPERTS)
    starts = jnp.cumsum(counts) - counts
    padded = (counts + MOE_BLOCK - 1) // MOE_BLOCK * MOE_BLOCK
    pad_ends = jnp.cumsum(padded)
    pad_starts = pad_ends - padded
    dest = pad_starts[se] + jnp.arange(n_asg) - starts[se]
    n_slot = n_asg + N_EXPERTS * MOE_BLOCK
    slot_tok = jnp.zeros((n_slot,), jnp.int32).at[dest].set(stok)
    slot_w = jnp.zeros((n_slot,), weight.dtype).at[dest].set(sw)
    n_blk = n_slot // MOE_BLOCK
    blk_expert = jnp.minimum(jnp.searchsorted(pad_ends, jnp.arange(n_blk) * MOE_BLOCK, side='right'),
                             N_EXPERTS - 1)
    xs = xf[slot_tok].reshape(n_blk, MOE_BLOCK, d)

    def expert_block(args):
        xb, e = args
        hdn = jax.nn.silu(xb @ w1[e]) * (xb @ w3[e])
        return hdn @ w2[e]

    ys = lax.map(expert_block, (xs, blk_expert)).reshape(n_slot, d)
    return jax.ops.segment_sum(ys * slot_w[:, None].astype(ys.dtype), slot_tok, num_segments=n_tok)


def hierarchical_moe(x, wg, bg, we, be, w1, w3, w2):
    bsz, s, d = x.shape
    n_tok = bsz * s
    xf = x.reshape(n_tok, d)
    group_logits = (xf @ wg).astype(F32) + bg.astype(F32)
    grp = jnp.argmax(group_logits, axis=-1)
    p_grp = jnp.take_along_axis(jax.nn.softmax(group_logits, axis=-1), grp[:, None], axis=-1)
    exp_logits = ((xf @ we).astype(F32) + be.astype(F32)).reshape(n_tok, N_GROUPS, EXPERTS_PER_GROUP)
    in_grp = jnp.take_along_axis(exp_logits, grp[:, None, None], axis=1)[:, 0]
    top_val, top_idx = lax.top_k(in_grp, EXPERT_TOPK)
    gate_w = jax.nn.softmax(top_val, axis=-1) * p_grp
    expert = grp[:, None] * EXPERTS_PER_GROUP + top_idx
    y = routed_expert_mlps(xf, expert.reshape(-1), gate_w.reshape(-1).astype(x.dtype), w1, w3, w2)
    return y.reshape(bsz, s, d)


def setup_inputs(seed: int = 0) -> dict:
    key = jax.random.key(seed)
    ks = jax.random.split(key, 22)

    def nrm(k, shape, scale):
        return jax.random.normal(k, shape, jnp.float32) * scale

    return {
        'x': nrm(ks[0], (BATCH, SEQ, D_MODEL), 1.0),
        'mem': nrm(ks[1], (BATCH, MEM_LEN, D_MODEL), 1.0),
        'rel_bias': nrm(ks[2], (N_BUCKETS, A_HEADS + C_Q_HEADS), 0.5),
        'w_in': nrm(ks[3], (DEPTH, D_MODEL, IN_WIDTH), D_MODEL ** -0.5),
        'w_branch': nrm(ks[4], (DEPTH, N_BRANCHES, BRANCH_WIDTH, D_MODEL), BRANCH_WIDTH ** -0.5),
        'w_out': nrm(ks[5], (DEPTH, D_MODEL, D_MODEL), DEEPNORM_BETA * D_MODEL ** -0.5),
        'hgrn_lb': 1.0 + nrm(ks[6], (DEPTH, B_HEADS * B_KEY_DIM), 0.5),
        'hgrn_norm_g': 1.0 + nrm(ks[7], (DEPTH, B_HEADS * B_VAL_DIM), 0.02),
        'c_sinks': nrm(ks[8], (DEPTH, C_Q_HEADS), 0.5),
        'xa_wq': nrm(ks[9], (DEPTH, D_MODEL, D_MODEL), D_MODEL ** -0.5),
        'xa_wkv': nrm(ks[10], (DEPTH, D_MODEL, 2 * D_MODEL), D_MODEL ** -0.5),
        'xa_wo': nrm(ks[11], (DEPTH, D_MODEL, D_MODEL), DEEPNORM_BETA * D_MODEL ** -0.5),
        'moe_wg': nrm(ks[12], (DEPTH, D_MODEL, N_GROUPS), D_MODEL ** -0.5),
        'moe_bg': nrm(ks[13], (DEPTH, N_GROUPS), 0.01),
        'moe_we': nrm(ks[14], (DEPTH, D_MODEL, N_EXPERTS), D_MODEL ** -0.5),
        'moe_be': nrm(ks[15], (DEPTH, N_EXPERTS), 0.01),
        'moe_w1': nrm(ks[16], (DEPTH, N_EXPERTS, D_MODEL, D_EXPERT), D_MODEL ** -0.5),
        'moe_w3': nrm(ks[17], (DEPTH, N_EXPERTS, D_MODEL, D_EXPERT), D_MODEL ** -0.5),
        'moe_w2': nrm(ks[18], (DEPTH, N_EXPERTS, D_EXPERT, D_MODEL), DEEPNORM_BETA * D_EXPERT ** -0.5),
        'ln_g': 1.0 + nrm(ks[19], (DEPTH, 3, D_MODEL), 0.02),
        'ln_b': nrm(ks[20], (DEPTH, 3, D_MODEL), 0.02),
    }


def reference(x, mem, rel_bias, w_in, w_branch, w_out, hgrn_lb, hgrn_norm_g, c_sinks,
              xa_wq, xa_wkv, xa_wo, moe_wg, moe_bg, moe_we, moe_be, moe_w1, moe_w3, moe_w2,
              ln_g, ln_b):
    lb_soft = jax.nn.softmax(hgrn_lb.astype(F32), axis=0)
    lower_bounds = jnp.cumsum(lb_soft, axis=0) - lb_soft[0]
    h = x
    for l in range(DEPTH):
        h = layer_norm(DEEPNORM_ALPHA * h + hybrid_mixer(h, w_in[l], w_branch[l], w_out[l], lower_bounds[l],
                                                         hgrn_norm_g[l], c_sinks[l], rel_bias),
                       ln_g[l, 0], ln_b[l, 0])
        h = layer_norm(DEEPNORM_ALPHA * h + memory_cross_attention(h, mem, xa_wq[l], xa_wkv[l], xa_wo[l]),
                       ln_g[l, 1], ln_b[l, 1])
        h = layer_norm(DEEPNORM_ALPHA * h + hierarchical_moe(h, moe_wg[l], moe_bg[l], moe_we[l], moe_be[l],
                                                             moe_w1[l], moe_w3[l], moe_w2[l]),
                       ln_g[l, 2], ln_b[l, 2])
    return h
```

```cpp
#include <hip/hip_runtime.h>
#include <hip/hip_bf16.h>
#include <cstdio>
#include <cstdint>
#include <cmath>
__device__ __forceinline__ int lane_now() { int l; asm volatile("v_mbcnt_lo_u32_b32 %0, -1, 0\n\tv_mbcnt_hi_u32_b32 %0, -1, %0" : "=v"(l)); return l; }
namespace pg8 {
#define PG8_LAS __attribute__((address_space(3)))
typedef unsigned short bf16_t;
typedef short bf16x8 __attribute__((ext_vector_type(8)));
typedef float f32x4 __attribute__((ext_vector_type(4)));
typedef unsigned u32x4 __attribute__((ext_vector_type(4)));
constexpr int BM = 256, BK = 64, HALF = 128, HTB = HALF * BK * 2  , STAGE_BYTES = 8 * HTB, NXCD = 8, WGM = 8;

__host__ __device__ __forceinline__ int lds_byte(int r, int c) { const int st = (r >> 4) * 2 + (c >> 5), rr = r & 15, cc = c & 31, ob = rr * 64 + cc * 2; return st * 1024 + (ob ^ (((ob >> 9) & 1) << 5)); }
__host__ __device__ __forceinline__ void stage_rc(int b, int& R, int& C) { const int st = b / 1024, sb = b % 1024, swz = sb ^ (((sb >> 9) & 1) << 5); R = (st >> 1) * 16 + swz / 64; C = (st & 1) * 32 + (swz % 64) / 2; }
__host__ __device__ __forceinline__ int perm32(int rho) { const int n = rho >> 4, i = rho & 15; return 8 * (i >> 2) + 4 * n + (i & 3); }

struct Unit { int pm, pn; };
struct Gemm { const bf16_t* A; const bf16_t* Bt; int M, N, K; };

struct StaticOrder {
    int nM, nN, nwg, G, c;
    __host__ __device__ void init(int M, int N, int G_, int c_) { nM = M / BM; nN = N / BM; nwg = nM * nN; G = G_; c = c_; }
    __host__ __device__ bool next(int i, Unit& u) const {
        const long L = (long)i * G + c; if (L >= nwg) return false;
        int wgid = (int)L; { const int q = nwg / NXCD, r = nwg % NXCD, xcd = wgid % NXCD, off = wgid / NXCD; wgid = (xcd < r ? xcd * (q + 1) : r * (q + 1) + (xcd - r) * q) + off; }
        const int nig = WGM * nN, gid = wgid / nig, fm = gid * WGM, gsz = (nM - fm) < WGM ? (nM - fm) : WGM;
        u.pm = fm + ((wgid % nig) % gsz); u.pn = (wgid % nig) / gsz; return true;
    }
    __device__ __forceinline__ void a_ready(const Unit&) const {}
    __device__ __forceinline__ void done(const Unit&) const {}
};

typedef float f32x2c_t __attribute__((ext_vector_type(2))); typedef __bf16 bf16x2c_t __attribute__((ext_vector_type(2)));
__device__ __forceinline__ unsigned cvt_pk_bf16(float lo, float hi) { const f32x2c_t v = {lo, hi}; const bf16x2c_t b = __builtin_convertvector(v, bf16x2c_t); return __builtin_bit_cast(unsigned, b); }
typedef float f32x2 __attribute__((ext_vector_type(2)));
__device__ __forceinline__ float silu_f(float x) { return x * __builtin_amdgcn_rcpf(1.0f + __expf(-x)); }
__device__ __forceinline__ float sigm_f(float x) { return __builtin_amdgcn_rcpf(1.0f + __expf(-x)); }
__device__ __forceinline__ u32x4 pack8(const f32x4& v0, const f32x4& v1) { u32x4 w; w.x = cvt_pk_bf16(v0[0], v0[1]); w.y = cvt_pk_bf16(v0[2], v0[3]); w.z = cvt_pk_bf16(v1[0], v1[1]); w.w = cvt_pk_bf16(v1[2], v1[3]); return w; }
constexpr float QK_C2 = 0.125f * 1.4426950408889634f;
constexpr float XQ_C2 = 0.0625f * 1.4426950408889634f;

template <int ACT> struct EpiStore {
    static constexpr bool PERM = true, AFTER_DRAIN = false;
    bf16_t* O; int ldc; float scale;
    __device__ __forceinline__ void operator()(const f32x4 (&acc)[2][2][4][2], const Unit& u, int wr, int wc, int fr, int fq) const {
        const int row0 = u.pm * BM + wr * 64 + fr, col0 = u.pn * BM + wc * 32 + 8 * fq;
#pragma unroll
        for (int ai = 0; ai < 2; ++ai)
#pragma unroll
            for (int m = 0; m < 4; ++m) { bf16_t* rowp = O + (size_t)(row0 + ai * HALF + m * 16) * ldc + col0;
#pragma unroll
                for (int bj = 0; bj < 2; ++bj) { f32x4 v0 = acc[ai][bj][m][0], v1 = acc[ai][bj][m][1];
                    if (ACT == 1) { for (int i = 0; i < 4; ++i) { v0[i] = sigm_f(v0[i]); v1[i] = sigm_f(v1[i]); } }
                    v0 = v0 * scale; v1 = v1 * scale; *(u32x4*)(rowp + bj * HALF) = pack8(v0, v1); } }
    }
};

struct EpiProj {
    static constexpr bool PERM = true, AFTER_DRAIN = false;
    bf16_t* P; float* LOGF; bf16_t* CVT; const float* lb;
    __device__ __forceinline__ void operator()(const f32x4 (&acc)[2][2][4][2], const Unit& u, int wr, int wc, int fr, int fq) const {
        const int pn = u.pn; const int row0 = u.pm * BM + wr * 64 + fr, col0 = pn * BM + wc * 32 + 8 * fq;
        const int mode = (pn <= 1 || pn == 17 || pn == 18) ? 1 : ((pn == 9 || pn == 10 || pn == 15 || pn == 16) ? 2 : ((pn == 11 || pn == 12) ? 3 : (pn == 19 ? 4 : 0)));
        if (mode == 3) {
            float lbv[2][8], omv[2][8];
#pragma unroll
            for (int bj = 0; bj < 2; ++bj)
#pragma unroll
                for (int i = 0; i < 8; ++i) { lbv[bj][i] = lb[col0 - 2816 + bj * HALF + i]; omv[bj][i] = 1.0f - lbv[bj][i]; }
#pragma unroll
            for (int ai = 0; ai < 2; ++ai)
#pragma unroll
                for (int m = 0; m < 4; ++m) { float* rowp = LOGF + (size_t)(row0 + ai * HALF + m * 16) * 512 + (col0 - 2816);
#pragma unroll
                    for (int bj = 0; bj < 2; ++bj) { f32x4 o[2];
#pragma unroll
                        for (int n = 0; n < 2; ++n)
#pragma unroll
                            for (int i = 0; i < 4; ++i) { const float z = acc[ai][bj][m][n][i]; const float e = __expf(-fabsf(z)); const float r = __builtin_amdgcn_rcpf(1.0f + e);
                                const float sp = z >= 0.f ? r : e * r, sn = z >= 0.f ? e * r : r;
                                const float k = omv[bj][4 * n + i] * sn;
                                const float f = lbv[bj][4 * n + i] + omv[bj][4 * n + i] * sp;
                                o[n][i] = (k < 0.5f) ? log1pf(-k) : logf(f); }
                        *(f32x4*)(rowp + bj * HALF) = o[0]; *(f32x4*)(rowp + bj * HALF + 4) = o[1]; } }
            return;
        }
#pragma unroll
        for (int ai = 0; ai < 2; ++ai)
#pragma unroll
            for (int m = 0; m < 4; ++m) { const int row = row0 + ai * HALF + m * 16; bf16_t* rowp = P + (size_t)row * 5120 + col0;
#pragma unroll
                for (int bj = 0; bj < 2; ++bj) { f32x4 v0 = acc[ai][bj][m][0], v1 = acc[ai][bj][m][1];
                    if (mode == 1) { v0 = v0 * QK_C2; v1 = v1 * QK_C2; }
                    if (mode == 2) { for (int i = 0; i < 4; ++i) { v0[i] = silu_f(v0[i]); v1[i] = silu_f(v1[i]); } }
                    const u32x4 w = pack8(v0, v1); *(u32x4*)(rowp + bj * HALF) = w;
                    if (mode == 4 && bj == 1) {
                        const int dfull = wc * 32 + 8 * fq; bf16_t* tp = CVT + ((size_t)(row >> 13) * 128 + dfull) * 8192 + (row & 8191);
                        tp[0 * 8192] = (bf16_t)(w.x & 0xffffu); tp[1 * 8192] = (bf16_t)(w.x >> 16); tp[2 * 8192] = (bf16_t)(w.y & 0xffffu); tp[3 * 8192] = (bf16_t)(w.y >> 16);
                        tp[4 * 8192] = (bf16_t)(w.z & 0xffffu); tp[5 * 8192] = (bf16_t)(w.z >> 16); tp[6 * 8192] = (bf16_t)(w.w & 0xffffu); tp[7 * 8192] = (bf16_t)(w.w >> 16); } } }
    }
};

struct EpiMerge {
    static constexpr bool PERM = true, AFTER_DRAIN = false;
    const bf16_t* GATE; float* MRG; bf16_t* OUT; int G3;
    __device__ __forceinline__ void operator()(const f32x4 (&acc)[2][2][4][2], const Unit& u, int wr, int wc, int fr, int fq) const {
        const int row0 = u.pm * BM + wr * 64 + fr, col0 = u.pn * BM + wc * 32 + 8 * fq;
#pragma unroll
        for (int ai = 0; ai < 2; ++ai)
#pragma unroll
            for (int m = 0; m < 4; ++m) { const size_t row = (size_t)(row0 + ai * HALF + m * 16);
#pragma unroll
                for (int bj = 0; bj < 2; ++bj) { const int col = col0 + bj * HALF;
                    const u32x4 gw = *(const u32x4*)(GATE + row * 3072 + G3 * 1024 + col);
                    f32x4 g0, g1; g0[0] = __uint_as_float(gw.x << 16); g0[1] = __uint_as_float(gw.x & 0xffff0000u); g0[2] = __uint_as_float(gw.y << 16); g0[3] = __uint_as_float(gw.y & 0xffff0000u);
                    g1[0] = __uint_as_float(gw.z << 16); g1[1] = __uint_as_float(gw.z & 0xffff0000u); g1[2] = __uint_as_float(gw.w << 16); g1[3] = __uint_as_float(gw.w & 0xffff0000u);
                    f32x4 v0 = acc[ai][bj][m][0] * g0, v1 = acc[ai][bj][m][1] * g1;
                    float* mp = MRG + row * 1024 + col;
                    if (G3 > 0) { v0 = v0 + *(const f32x4*)mp; v1 = v1 + *(const f32x4*)(mp + 4); }
                    if (G3 < 2) { *(f32x4*)mp = v0; *(f32x4*)(mp + 4) = v1; }
                    else *(u32x4*)(OUT + row * 1024 + col) = pack8(v0, v1); } }
    }
};

struct EpiResid {
    static constexpr bool PERM = true, AFTER_DRAIN = false;
    const float* H; float* T; float alpha;
    __device__ __forceinline__ void operator()(const f32x4 (&acc)[2][2][4][2], const Unit& u, int wr, int wc, int fr, int fq) const {
        const int row0 = u.pm * BM + wr * 64 + fr, col0 = u.pn * BM + wc * 32 + 8 * fq;
#pragma unroll
        for (int ai = 0; ai < 2; ++ai)
#pragma unroll
            for (int m = 0; m < 4; ++m) { const size_t off = (size_t)(row0 + ai * HALF + m * 16) * 1024 + col0;
#pragma unroll
                for (int bj = 0; bj < 2; ++bj) { const f32x4 h0 = *(const f32x4*)(H + off + bj * HALF), h1 = *(const f32x4*)(H + off + bj * HALF + 4);
                    *(f32x4*)(T + off + bj * HALF) = h0 * alpha + acc[ai][bj][m][0]; *(f32x4*)(T + off + bj * HALF + 4) = h1 * alpha + acc[ai][bj][m][1]; } }
    }
};

struct EpiMoeUp {
    static constexpr bool PERM = true, AFTER_DRAIN = false;
    bf16_t* HID;
    __device__ __forceinline__ void operator()(const f32x4 (&acc)[2][2][4][2], const Unit& u, int wr, int wc, int fr, int fq) const {
        const int row0 = u.pm * BM + wr * 64 + fr, col0 = (u.pn & 3) * 128 + wc * 32 + 8 * fq;
#pragma unroll
        for (int ai = 0; ai < 2; ++ai)
#pragma unroll
            for (int m = 0; m < 4; ++m) { f32x4 v0, v1;
#pragma unroll
                for (int i = 0; i < 4; ++i) { v0[i] = silu_f(acc[ai][0][m][0][i]) * acc[ai][1][m][0][i]; v1[i] = silu_f(acc[ai][0][m][1][i]) * acc[ai][1][m][1][i]; }
                *(u32x4*)(HID + (size_t)(row0 + ai * HALF + m * 16) * 512 + col0) = pack8(v0, v1); }
    }
};
struct EpiMoeDown {
    static constexpr bool PERM = true, AFTER_DRAIN = false;
    bf16_t* Y; const int* slot_asg;
    __device__ __forceinline__ void operator()(const f32x4 (&acc)[2][2][4][2], const Unit& u, int wr, int wc, int fr, int fq) const {
        const int row0 = u.pm * BM + wr * 64 + fr, col0 = (u.pn & 3) * BM + wc * 32 + 8 * fq;
#pragma unroll
        for (int ai = 0; ai < 2; ++ai)
#pragma unroll
            for (int m = 0; m < 4; ++m) { const int asg = slot_asg[row0 + ai * HALF + m * 16];
                if (asg >= 0) { bf16_t* rowp = Y + (size_t)asg * 1024 + col0;
#pragma unroll
                    for (int bj = 0; bj < 2; ++bj) *(u32x4*)(rowp + bj * HALF) = pack8(acc[ai][bj][m][0], acc[ai][bj][m][1]); } }
    }
};
struct MoeOrder {
    const int* blke; int nunits, G, c;
    __device__ __forceinline__ bool next(int i, Unit& u) const { const int L = i * G + c; if (L >= nunits) return false; const int blk = L >> 2; u.pm = blk; u.pn = blke[blk] * 4 + (L & 3); return true; }
    __device__ __forceinline__ void a_ready(const Unit&) const {}
    __device__ __forceinline__ void done(const Unit&) const {}
};
template <class Epi, class Sched, bool ALIGN_EPI = false, bool SP2 = false>
__device__ __forceinline__ void gemm_phase(PG8_LAS unsigned char* lds, int tid_in, const Gemm g, const Sched& S, const Epi& E) {
    const int tid = tid_in * 64 + lane_now();
    const int wid = __builtin_amdgcn_readfirstlane(tid >> 6), lane = tid & 63, wr = wid >> 2, wc = wid & 3, fr = lane & 15, fq = lane >> 4;
    const int K = g.K, nt = K / BK;
    unsigned voffA[2], voffB[2];
#pragma unroll
    for (int i = 0; i < 2; ++i) { int R, C; stage_rc(tid * 16 + i * 8192, R, C); const int Rb = Epi::PERM ? ((R & ~31) + perm32(R & 31)) : R;
        voffA[i] = (unsigned)(R * K + C) * 2u; voffB[i] = (unsigned)(Rb * K + C) * 2u; }
    const size_t kstep = (size_t)(BK * 2);
    const size_t hstep = (size_t)HALF * K * 2;
    const size_t tstep = 2 * hstep;
    const unsigned ldsw = (unsigned)wid * 1024u;
    const int aoff = lds_byte(wr * 64 + fr, fq * 8), boff = lds_byte(wc * 32 + fr, fq * 8);
#define PG8_SA(b, h) (((b) * 2 + (h)) * HTB)
#define PG8_SB(b, h) ((4 + (b) * 2 + (h)) * HTB)
#define PG8_STAGE(bufoff, gbase, voff) do { _Pragma("unroll") for (int _i = 0; _i < 2; ++_i) \
        __builtin_amdgcn_global_load_lds((const unsigned*)((const char*)(gbase) + (voff)[_i]), (PG8_LAS unsigned*)(lds + (bufoff) + ldsw + _i * 8192), 16, 0, 0); } while (0)
#define PG8_LDA(dst, b, h) do { _Pragma("unroll") for (int m = 0; m < 4; ++m) _Pragma("unroll") for (int k = 0; k < 2; ++k) dst[m][k] = *(const PG8_LAS bf16x8*)(lds + PG8_SA(b, h) + aoff + m * 2048 + k * 1024); } while (0)
#define PG8_LDB(dst, b, h) do { _Pragma("unroll") for (int n = 0; n < 2; ++n) _Pragma("unroll") for (int k = 0; k < 2; ++k) dst[n][k] = *(const PG8_LAS bf16x8*)(lds + PG8_SB(b, h) + boff + n * 2048 + k * 1024); } while (0)
#define PG8_MMA(ai, bj, At, Bt) do { __builtin_amdgcn_s_setprio(1); _Pragma("unroll") for (int m = 0; m < 4; ++m) _Pragma("unroll") for (int n = 0; n < 2; ++n) _Pragma("unroll") for (int k = 0; k < 2; ++k) \
        acc[ai][bj][m][n] = __builtin_amdgcn_mfma_f32_16x16x32_bf16(Bt[n][k], At[m][k], acc[ai][bj][m][n], 0, 0, 0); __builtin_amdgcn_s_setprio(0); } while (0)
#define PG8_WAIT_V(n) asm volatile("s_waitcnt vmcnt(" #n ")" ::: "memory")
#define PG8_WAIT_L(n) asm volatile("s_waitcnt lgkmcnt(" #n ")" ::: "memory")
#define PG8_BAR __builtin_amdgcn_s_barrier()
#define PG8_SCHED __builtin_amdgcn_sched_barrier(0)
    Unit cur, nxt; int ui = 0;
    if (!S.next(0, cur)) return;
    f32x4 acc[2][2][4][2];
#pragma unroll
    for (int a = 0; a < 2; ++a)
#pragma unroll
        for (int b = 0; b < 2; ++b)
#pragma unroll
            for (int m = 0; m < 4; ++m)
#pragma unroll
                for (int n = 0; n < 2; ++n) acc[a][b][m][n] = (f32x4){0.f, 0.f, 0.f, 0.f};
    bf16x8 At[4][2], B0[2][2], B1[2][2];
    const char* cA = (const char*)g.A + (size_t)cur.pm * tstep; const char* cB = (const char*)g.Bt + (size_t)cur.pn * tstep;
    S.a_ready(cur);
    if constexpr (SP2) {
        PG8_STAGE(PG8_SB(0, 0), cB, voffB); PG8_STAGE(PG8_SB(0, 1), cB + hstep, voffB); PG8_STAGE(PG8_SA(0, 0), cA, voffA); PG8_STAGE(PG8_SA(0, 1), cA + hstep, voffA);
        if (wr == 1) PG8_BAR;
        PG8_WAIT_V(2); PG8_BAR;
        PG8_STAGE(PG8_SB(1, 0), cB + kstep, voffB); PG8_STAGE(PG8_SA(1, 0), cA + kstep, voffA); PG8_STAGE(PG8_SB(1, 1), cB + hstep + kstep, voffB);
        PG8_WAIT_V(6); PG8_BAR;
    } else {
        PG8_STAGE(PG8_SB(0, 0), cB, voffB); PG8_STAGE(PG8_SA(0, 0), cA, voffA); PG8_STAGE(PG8_SB(0, 1), cB + hstep, voffB); PG8_STAGE(PG8_SA(0, 1), cA + hstep, voffA);
        if (wr == 1) PG8_BAR;
        PG8_WAIT_V(4); PG8_BAR;
        PG8_STAGE(PG8_SB(1, 0), cB + kstep, voffB); PG8_STAGE(PG8_SA(1, 0), cA + kstep, voffA); PG8_STAGE(PG8_SB(1, 1), cB + hstep + kstep, voffB);
        PG8_WAIT_V(6); PG8_BAR;
    }
    for (;;) {
        const bool has_next = S.next(ui + 1, nxt);
        const char* nA = has_next ? (const char*)g.A + (size_t)nxt.pm * tstep : cA; const char* nB = has_next ? (const char*)g.Bt + (size_t)nxt.pn * tstep : cB;
        for (int t = 0; t < nt; t += 2) {
            const bool last = (t == nt - 2);
            const char* a1 = cA + (size_t)(t + 1) * kstep;
            const char* a2 = last ? nA : cA + (size_t)(t + 2) * kstep; const char* b2 = last ? nB : cB + (size_t)(t + 2) * kstep;
            const char* a3 = a2 + kstep; const char* b3 = b2 + kstep;
            if (last && has_next) S.a_ready(nxt);
            if constexpr (SP2) {
            PG8_LDB(B0, 0, 0); PG8_LDB(B1, 0, 1); PG8_SCHED; PG8_LDA(At, 0, 0); PG8_STAGE(PG8_SA(1, 1), a1 + hstep, voffA);
            PG8_WAIT_V(8); PG8_WAIT_L(0); PG8_BAR; PG8_MMA(0, 0, At, B0); PG8_MMA(0, 1, At, B1); PG8_BAR; PG8_SCHED;
            PG8_LDA(At, 0, 1); PG8_STAGE(PG8_SB(0, 0), b2, voffB); PG8_STAGE(PG8_SB(0, 1), b2 + hstep, voffB); PG8_STAGE(PG8_SA(0, 0), a2, voffA);
            PG8_WAIT_V(8); PG8_WAIT_L(0); PG8_BAR; PG8_MMA(1, 0, At, B0); PG8_MMA(1, 1, At, B1); PG8_BAR; PG8_SCHED;
            PG8_LDB(B0, 1, 0); PG8_LDB(B1, 1, 1); PG8_SCHED; PG8_LDA(At, 1, 0); PG8_STAGE(PG8_SA(0, 1), a2 + hstep, voffA);
            PG8_WAIT_V(8); PG8_WAIT_L(0); PG8_BAR; PG8_MMA(0, 0, At, B0); PG8_MMA(0, 1, At, B1); PG8_BAR; PG8_SCHED;
            PG8_LDA(At, 1, 1); PG8_STAGE(PG8_SB(1, 0), b3, voffB); PG8_STAGE(PG8_SB(1, 1), b3 + hstep, voffB); PG8_STAGE(PG8_SA(1, 0), a3, voffA);
            PG8_WAIT_V(8); PG8_WAIT_L(0); PG8_BAR; PG8_MMA(1, 0, At, B0); PG8_MMA(1, 1, At, B1); PG8_BAR; PG8_SCHED;
            } else {
            PG8_LDB(B0, 0, 0); PG8_SCHED; PG8_LDA(At, 0, 0); PG8_STAGE(PG8_SA(1, 1), a1 + hstep, voffA);
            PG8_WAIT_L(8); PG8_BAR; PG8_WAIT_L(0); PG8_MMA(0, 0, At, B0); PG8_BAR; PG8_SCHED;
            PG8_LDB(B1, 0, 1); PG8_STAGE(PG8_SB(0, 0), b2, voffB);
            PG8_BAR; PG8_WAIT_L(0); PG8_MMA(0, 1, At, B1); PG8_BAR;
            PG8_LDA(At, 0, 1); PG8_STAGE(PG8_SA(0, 0), a2, voffA);
            PG8_BAR; PG8_WAIT_L(0); PG8_MMA(1, 0, At, B0); PG8_BAR; PG8_SCHED;
            PG8_STAGE(PG8_SB(0, 1), b2 + hstep, voffB);
            PG8_WAIT_V(6); PG8_BAR; PG8_MMA(1, 1, At, B1); PG8_BAR;
            PG8_LDB(B0, 1, 0); PG8_SCHED; PG8_LDA(At, 1, 0); PG8_STAGE(PG8_SA(0, 1), a2 + hstep, voffA);
            PG8_WAIT_L(8); PG8_BAR; PG8_WAIT_L(0); PG8_MMA(0, 0, At, B0); PG8_BAR; PG8_SCHED;
            PG8_LDB(B1, 1, 1); PG8_STAGE(PG8_SB(1, 0), b3, voffB);
            PG8_BAR; PG8_WAIT_L(0); PG8_MMA(0, 1, At, B1); PG8_BAR;
            PG8_LDA(At, 1, 1); PG8_STAGE(PG8_SA(1, 0), a3, voffA);
            PG8_BAR; PG8_WAIT_L(0); PG8_MMA(1, 0, At, B0); PG8_BAR; PG8_SCHED;
            PG8_STAGE(PG8_SB(1, 1), b3 + hstep, voffB);
            PG8_WAIT_V(6); PG8_BAR; PG8_MMA(1, 1, At, B1); PG8_BAR;
            }
        }
        if constexpr (ALIGN_EPI) { if (wr == 0) PG8_BAR; }
        if constexpr (!Epi::AFTER_DRAIN) { E(acc, cur, wr, wc, fr, fq); S.done(cur); }
        if (!has_next) break;
#pragma unroll
        for (int a = 0; a < 2; ++a)
#pragma unroll
            for (int b = 0; b < 2; ++b)
#pragma unroll
                for (int m = 0; m < 4; ++m)
#pragma unroll
                    for (int n = 0; n < 2; ++n) acc[a][b][m][n] = (f32x4){0.f, 0.f, 0.f, 0.f};
        cur = nxt; cA = nA; cB = nB; ++ui;
        if constexpr (ALIGN_EPI) { if (wr == 1) PG8_BAR; }
    }
    PG8_WAIT_V(0);
    if constexpr (!ALIGN_EPI) { if (wr == 0) PG8_BAR; }
    PG8_BAR;
    if constexpr (Epi::AFTER_DRAIN) { E.fused(acc, cur, wr, wc, fr, fq, lds, wid, lane); S.done(cur); }
#undef PG8_SA
#undef PG8_SB
#undef PG8_STAGE
#undef PG8_LDA
#undef PG8_LDB
#undef PG8_MMA
#undef PG8_WAIT_V
#undef PG8_WAIT_L
#undef PG8_BAR
#undef PG8_SCHED
}
}
namespace attn_body {
using bf16=__hip_bfloat16;
using bf16x8=__attribute__((ext_vector_type(8)))short;
using s16x4=__attribute__((ext_vector_type(4)))short;
using f32x16=__attribute__((ext_vector_type(16)))float;
using u32x4=__attribute__((ext_vector_type(4)))unsigned;
constexpr int BATCH=2,NHEAD=8,SEQ=8192,D=64,DM=5120,DMO=512;
constexpr int NW=8,QBLK=32,QB=QBLK*NW,KVBLK=64,NQB=SEQ/QB;
constexpr int ATTN_UNIT_ROWS=QB;
__device__ __forceinline__ int crow(int r,int hi){return (r&3)+8*(r>>2)+4*hi;}
#define SBAR() __builtin_amdgcn_sched_barrier(0)
__device__ __forceinline__ void cmask(f32x16&p0,f32x16&p1,int jb,int qrel,int hi){
  const float NEG=-INFINITY; int kb=64*jb+4*hi;
  #pragma unroll
  for(int r=0;r<16;++r){int kv=kb+(r&3)+8*(r>>2); if(kv>qrel)p0[r]=NEG; if(kv+32>qrel)p1[r]=NEG;}
}

constexpr int NSLOT=3, SLOTB=8192;
constexpr int LDS_K=0, LDS_V=NSLOT*SLOTB, LDS_WS=2*NSLOT*SLOTB, LDS_OST=LDS_WS+NW*64*4, LDS_BYTES=LDS_OST+NW*4096;
constexpr float C2=0.125f*1.4426950408889634f;
__device__ __forceinline__ void mkinit(f32x16&p0,f32x16&p1,unsigned long long mw,int hi,float cbm){
  const unsigned lo=(unsigned)mw>>(4*hi), hw=(unsigned)(mw>>32)>>(4*hi); const int ci=__builtin_bit_cast(int,cbm), ni=(int)0xC5800000u;
  #pragma unroll
  for(int r=0;r<16;++r){const int pos=(r&3)+8*(r>>2);
    const int m0=((int)(lo<<(31-pos)))>>31, m1=((int)(hw<<(31-pos)))>>31;
    p0[r]=__builtin_bit_cast(float,(m0&ci)|(~m0&ni)); p1[r]=__builtin_bit_cast(float,(m1&ci)|(~m1&ni));}
}
__device__ __forceinline__ void biasadd(f32x16&p0,f32x16&p1,const __attribute__((address_space(3))) float*tab,int dq,int hi){
  #pragma unroll
  for(int r=0;r<16;r+=2){
    float t[4];
    #pragma unroll
    for(int k=0;k<2;++k){const int kv=((r+k)&3)+8*((r+k)>>2)+4*hi; int d0=dq-kv, d1=dq-kv-32; d0=d0<0?0:(d0>128?128:d0); d1=d1<0?0:(d1>128?128:d1); t[2*k]=tab[d0]; t[2*k+1]=tab[d1];}
    asm volatile("s_waitcnt lgkmcnt(0)":"+v"(t[0]),"+v"(t[1]),"+v"(t[2]),"+v"(t[3])::"memory");
    p0[r]+=t[0]; p1[r]+=t[1]; p0[r+1]+=t[2]; p1[r+1]+=t[3];
    __builtin_amdgcn_sched_barrier(0);
  }
}
__device__ __forceinline__ void glds16(const void*gsrc,unsigned lds_dst){unsigned keep;
  asm volatile("s_mov_b32 %0, m0\n\ts_mov_b32 m0, %2\n\ts_nop 0\n\tglobal_load_lds_dwordx4 %1, off\n\ts_mov_b32 m0, %0":"=&s"(keep):"v"(gsrc),"s"(lds_dst):"memory");}
__device__ __forceinline__ float max3f(float a,float b,float c){float r;asm("v_max3_f32 %0, %1, %2, %3":"=v"(r):"v"(a),"v"(b),"v"(c));return r;}
__device__ __forceinline__ float max2f(float a,float b){float r;asm("v_max_f32_e32 %0, %1, %2":"=v"(r):"v"(a),"v"(b));return r;}
__device__ __forceinline__ float fadd_s(float a,float b){float r;asm("v_add_f32_e32 %0, %1, %2":"=v"(r):"v"(a),"v"(b));return r;}
__device__ __forceinline__ float fsub_s(float a,float b){float r;asm("v_sub_f32_e32 %0, %1, %2":"=v"(r):"v"(a),"v"(b));return r;}
typedef float f32x2_t __attribute__((ext_vector_type(2))); typedef __bf16 bf16x2_t __attribute__((ext_vector_type(2)));
__device__ __forceinline__ unsigned cvtpk_s(float lo,float hi){f32x2_t v={lo,hi};bf16x2_t b=__builtin_convertvector(v,bf16x2_t);return __builtin_bit_cast(unsigned,b);}
#define WAIT_BAR(N) asm volatile("s_waitcnt vmcnt(" #N ") lgkmcnt(0)\n\ts_barrier":::"memory")

__device__ __forceinline__ void qkt(f32x16&p0,f32x16&p1,const char*Kslot,const bf16x8*qr,int r32,int hi){
  const char*kb=Kslot+hi*1024+r32*16;
  #pragma unroll
  for(int d0=0;d0<4;++d0){
    const bf16x8 b0=*reinterpret_cast<const bf16x8*>(kb+d0*2048);
    const bf16x8 b1=*reinterpret_cast<const bf16x8*>(kb+d0*2048+512);
    {p0=__builtin_amdgcn_mfma_f32_32x32x16_bf16(b0,qr[d0],p0,0,0,0);p1=__builtin_amdgcn_mfma_f32_32x32x16_bf16(b1,qr[d0],p1,0,0,0);}}
}
typedef __attribute__((address_space(3))) const char* lds_cptr;
typedef short v4i16_t __attribute__((ext_vector_type(4)));
__device__ __forceinline__ void kload8(bf16x8*kf,lds_cptr kp){
  kf[0]=*(const __attribute__((address_space(3))) bf16x8*)(kp);      kf[1]=*(const __attribute__((address_space(3))) bf16x8*)(kp+512);
  kf[2]=*(const __attribute__((address_space(3))) bf16x8*)(kp+2048); kf[3]=*(const __attribute__((address_space(3))) bf16x8*)(kp+2560);
  kf[4]=*(const __attribute__((address_space(3))) bf16x8*)(kp+4096); kf[5]=*(const __attribute__((address_space(3))) bf16x8*)(kp+4608);
  kf[6]=*(const __attribute__((address_space(3))) bf16x8*)(kp+6144); kf[7]=*(const __attribute__((address_space(3))) bf16x8*)(kp+6656);
}
__device__ __forceinline__ void kload2(bf16x8*kf,lds_cptr kp,int j){ kf[2*j]=*(const __attribute__((address_space(3))) bf16x8*)(kp+j*2048); kf[2*j+1]=*(const __attribute__((address_space(3))) bf16x8*)(kp+j*2048+512); }
__device__ __forceinline__ s16x4 vtr(lds_cptr p){ return __builtin_bit_cast(s16x4,__builtin_amdgcn_ds_read_tr16_b64_v4i16((__attribute__((address_space(3))) v4i16_t*)p)); }
__device__ __forceinline__ float rowmax(const f32x16&p0,const f32x16&p1){
  float a=max3f(p0[0],p0[1],p1[0]),b=max3f(p0[2],p0[3],p1[1]);a=max3f(a,p1[2],p1[3]);
  #pragma unroll
  for(int r=4;r<16;r+=4){a=max3f(a,p0[r],p0[r+1]);b=max3f(b,p0[r+2],p0[r+3]);a=max3f(a,p1[r],p1[r+1]);b=max3f(b,p1[r+2],p1[r+3]);}
  const float m=max2f(a,b);
  auto rr=__builtin_amdgcn_permlane32_swap(__float_as_uint(m),__float_as_uint(m),false,false);
  return max2f(__uint_as_float(rr[0]),__uint_as_float(rr[1]));
}
__device__ __forceinline__ void pv(f32x16*o,int vb,bf16x8 pa0,bf16x8 pa1,bf16x8 pa2,bf16x8 pa3){
  #pragma unroll
  for(int d0=0;d0<2;++d0){s16x4 lo[4],hi[4];
    #pragma unroll
    for(int ks=0;ks<4;++ks){
      asm volatile("ds_read_b64_tr_b16 %0,%1 offset:%c2":"=&v"(lo[ks]):"v"(vb),"i"(d0*4096+ks*1024):"memory");
      asm volatile("ds_read_b64_tr_b16 %0,%1 offset:%c2":"=&v"(hi[ks]):"v"(vb),"i"(d0*4096+ks*1024+512):"memory");}
    asm volatile("s_waitcnt lgkmcnt(0)":::"memory");SBAR();
    #define PK(k) (bf16x8){lo[k][0],lo[k][1],lo[k][2],lo[k][3],hi[k][0],hi[k][1],hi[k][2],hi[k][3]}
    o[d0]=__builtin_amdgcn_mfma_f32_32x32x16_bf16(pa0,PK(0),o[d0],0,0,0);
    o[d0]=__builtin_amdgcn_mfma_f32_32x32x16_bf16(pa1,PK(1),o[d0],0,0,0);
    o[d0]=__builtin_amdgcn_mfma_f32_32x32x16_bf16(pa2,PK(2),o[d0],0,0,0);
    o[d0]=__builtin_amdgcn_mfma_f32_32x32x16_bf16(pa3,PK(3),o[d0],0,0,0);
    #undef PK
  }
}

#ifndef ATTN_STORE16
#define ATTN_STORE16(p,v) (*(u32x4*)(p)=(v))
#endif
template<int THRL> __device__ __forceinline__ void attn_unit(int b,int h,int qb,const bf16*Q,const bf16*__restrict__ K,const bf16*__restrict__ V,bf16*O,char*shm,int tid_in,const unsigned char*__restrict__ MSK,const __attribute__((address_space(3))) float*tabA,float cb){
  const int tid=tid_in*64+lane_now();
  const int lane=tid&63,r32=lane&31,hi=lane>>5; const int wid=__builtin_amdgcn_readfirstlane(tid>>6);
  const long rowbase=(long)b*SEQ; const int q0=qb*QB;
  const bf16*Qw=Q+(rowbase+q0+wid*QBLK)*DM+h*D;
  const unsigned moff=(unsigned)(rowbase+q0+wid*QBLK+r32)*1024u;
  #define MROW(t) (*(const unsigned long long*)(MSK+(moff+8u*(unsigned)(t))))
  const bf16*Kh=K+rowbase*DM+h*D,*Vh=V+rowbase*DM+h*D;
  const unsigned lds0=(unsigned)(uintptr_t)shm;
  float*wsf=(float*)(shm+LDS_WS)+wid*64;
  const bf16*ksrc=Kh+(long)lane*DM+wid*8;
  const bf16*vsrc=Vh+(long)(16*(wid&3)+(lane>>2))*DM+(wid>>2)*32+(lane&3)*8;
  const unsigned kdst=lds0+LDS_K+wid*1024, vdst=lds0+LDS_V+wid*1024;
  #define DMA_K(t,slot) glds16(ksrc+(long)(t)*KVBLK*DM,(unsigned)__builtin_amdgcn_readfirstlane(kdst+(slot)))
  #define DMA_V(t,slot) glds16(vsrc+(long)(t)*KVBLK*DM,(unsigned)__builtin_amdgcn_readfirstlane(vdst+(slot)))
  const int vb0=(int)(lds0+LDS_V)+((lane>>4)&1)*32+(lane&3)*8+(4*hi+((lane&15)>>2))*64;
  const char*Kbase=shm+LDS_K; bf16x8 kf[8];
  const lds_cptr shm3=(lds_cptr)shm; const lds_cptr kp0=shm3+LDS_K+hi*1024+r32*16; const lds_cptr vp0=shm3+LDS_V+((lane>>4)&1)*32+(lane&3)*8+(4*hi+((lane&15)>>2))*64;
  const int NT=(q0+QB)/KVBLK;
  DMA_K(0,0);DMA_V(0,0);DMA_K(1,SLOTB);
  bf16x8 qr[4];
  #pragma unroll
  for(int d0=0;d0<4;++d0)qr[d0]=*reinterpret_cast<const bf16x8*>(&Qw[(long)r32*DM+d0*16+hi*8]);
  unsigned long long mw=MROW(0);
  float mhat=0.f,l_reg=0.f;f32x16 o[2];o[0]=f32x16{};o[1]=f32x16{};float cbm=cb;
  const int qrel=wid*QBLK+r32;
  #define CMASK(P0,P1,t,MW) do{ int jb2_=(t)-(NT-6); if(jb2_>=0)biasadd(P0,P1,tabA,q0+qrel-64*(t),hi); int jb_=(t)-(NT-4); if(jb_>=0)cmask(P0,P1,jb_,qrel,hi);}while(0)
  bool resc=false;
  #define START(P0,P1) do{ const float rm=rowmax(P0,P1); resc=false; \
    { const float dl=rm; mhat=fadd_s(mhat,dl); \
      _Pragma("unroll") for(int r=0;r<16;++r){P0[r]=fsub_s(P0[r],dl);P1[r]=fsub_s(P1[r],dl);} \
      cbm=cb-mhat; } \
    _Pragma("unroll") for(int r=0;r<16;++r)P0[r]=__builtin_amdgcn_exp2f(P0[r]); }while(0)
  #define RESC() do{ if(resc){ asm volatile("s_waitcnt lgkmcnt(0)":::"memory"); \
      _Pragma("unroll") for(int d_=0;d_<2;++d_) _Pragma("unroll") for(int r=0;r<16;++r)o[d_][r]*=wsf[crow(r,hi)]; } }while(0)
  f32x16 pA0,pA1,pB0,pB1;
  int sl_prev=0,sl_cur=0,sl_next=SLOTB;
  #define ROT() do{sl_prev=sl_cur;sl_cur=sl_next;sl_next=(sl_next==(NSLOT-1)*SLOTB)?0:sl_next+SLOTB;}while(0)
  DMA_K(2,2*SLOTB);
  WAIT_BAR(3);
  mkinit(pA0,pA1,mw,hi,cbm); mw=MROW(1); qkt(pA0,pA1,Kbase,qr,r32,hi);asm volatile("s_nop 15\n\ts_nop 7":"+v"(pA0),"+v"(pA1));CMASK(pA0,pA1,0,mw);
  START(pA0,pA1);
  _Pragma("unroll") for(int r=0;r<16;++r)pA1[r]=__builtin_amdgcn_exp2f(pA1[r]);
  WAIT_BAR(0);
  DMA_K(3,0);DMA_V(1,SLOTB);
  ROT();
  kload8(kf,kp0+sl_cur);
  WAIT_BAR(2);
  s16x4 vlo[8],vhi[8]; u32x4 pw0,pw1,pw2,pw3;
  #define PKW(P,B) cvtpk_s(P[B],P[B+1])
  #define PAF(k) __builtin_bit_cast(bf16x8,pw##k)
  #define VFR(i) (bf16x8){vlo[i][0],vlo[i][1],vlo[i][2],vlo[i][3],vhi[i][0],vhi[i][1],vhi[i][2],vhi[i][3]}
  #define PIN(x) asm volatile("":"+v"(x))
  #define MX3(a,b,c) __builtin_fmaxf(__builtin_fmaxf((a),(b)),(c))
  #define GAPA(MF,A0,A1,A2,A3,W0,W1,PW) do{ MF; sacc+=A0; sacc+=A1; sacc+=A2; sacc+=A3; PIN(sacc); W0; W1; PIN(PW); SBAR(); }while(0)
  #define EX(v) __builtin_amdgcn_exp2f(v)
  #define GAPB(MF,X,B) do{ MF; X[B]=EX(X[B]); X[B+1]=EX(X[B+1]); X[B+2]=EX(X[B+2]); X[B+3]=EX(X[B+3]); PIN(X); SBAR(); }while(0)
  #define VRD(i) do{ vlo[i]=vtr(vp_+(((i)>>2)*4096+((i)&3)*1024)); vhi[i]=vtr(vp_+(((i)>>2)*4096+((i)&3)*1024+512)); }while(0)
  #define KRD(G,j) do{ if(G){ kload2(kf,kp0+sl_next,j); SBAR(); } }while(0)
  #define STEP(C0,C1,P0,P1,t,GK,GV,GL,MWU,MWL) do{ SBAR(); mkinit(C0,C1,mw,hi,cbm); mw=MROW((t)+1); SBAR(); \
    const lds_cptr vp_=vp0+sl_prev; \
    VRD(0); SBAR(); float sacc=(P0[0]+P0[1]); \
    GAPA(C0=__builtin_amdgcn_mfma_f32_32x32x16_bf16(kf[0],qr[0],C0,0,0,0), P0[2],P0[3],P0[4],P0[5],     pw0[0]=PKW(P0,0), pw0[1]=PKW(P0,2), pw0); \
    VRD(4); SBAR(); GAPA(C1=__builtin_amdgcn_mfma_f32_32x32x16_bf16(kf[1],qr[0],C1,0,0,0), P0[6],P0[7],P0[8],P0[9],     pw0[2]=PKW(P0,4), pw0[3]=PKW(P0,6), pw0); \
    VRD(1); SBAR(); GAPA(C0=__builtin_amdgcn_mfma_f32_32x32x16_bf16(kf[2],qr[1],C0,0,0,0),   P0[10],P0[11],P0[12],P0[13], pw1[0]=PKW(P0,8), pw1[1]=PKW(P0,10), pw1); \
    VRD(5); SBAR(); GAPA(C1=__builtin_amdgcn_mfma_f32_32x32x16_bf16(kf[3],qr[1],C1,0,0,0),   P0[14],P0[15],P1[0],P1[1],   pw1[2]=PKW(P0,12),pw1[3]=PKW(P0,14), pw1); \
    VRD(2); SBAR(); GAPA(C0=__builtin_amdgcn_mfma_f32_32x32x16_bf16(kf[4],qr[2],C0,0,0,0),   P1[2],P1[3],P1[4],P1[5],     pw2[0]=PKW(P1,0), pw2[1]=PKW(P1,2), pw2); \
    VRD(6); SBAR(); GAPA(C1=__builtin_amdgcn_mfma_f32_32x32x16_bf16(kf[5],qr[2],C1,0,0,0),   P1[6],P1[7],P1[8],P1[9],     pw2[2]=PKW(P1,4), pw2[3]=PKW(P1,6), pw2); \
    VRD(3); SBAR(); GAPA(C0=__builtin_amdgcn_mfma_f32_32x32x16_bf16(kf[6],qr[3],C0,0,0,0),   P1[10],P1[11],P1[12],P1[13], pw3[0]=PKW(P1,8), pw3[1]=PKW(P1,10), pw3); \
    VRD(7); SBAR(); GAPA(C1=__builtin_amdgcn_mfma_f32_32x32x16_bf16(kf[7],qr[3],C1,0,0,0),   P1[14],P1[15],0.f,0.f,       pw3[2]=PKW(P1,12),pw3[3]=PKW(P1,14), pw3); \
    l_reg+=sacc; \
    if(GK){DMA_K((t)+3,sl_cur);} if(GV){DMA_V((t)+1,sl_next);} \
    CMASK(C0,C1,t,0); \
    { float a=MX3(C0[0],C0[1],C1[0]),b=MX3(C0[2],C0[3],C1[1]); a=MX3(a,C1[2],C1[3]); \
      _Pragma("unroll") for(int r=4;r<16;r+=4){a=MX3(a,C0[r],C0[r+1]);b=MX3(b,C0[r+2],C0[r+3]);a=MX3(a,C1[r],C1[r+1]);b=MX3(b,C1[r+2],C1[r+3]);} \
      float rm=__builtin_fmaxf(a,b); { auto rr=__builtin_amdgcn_permlane32_swap(__float_as_uint(rm),__float_as_uint(rm),false,false); rm=__builtin_fmaxf(__uint_as_float(rr[0]),__uint_as_float(rr[1])); } \
      resc=false; \
      if(__builtin_expect(__any(rm>(float)THRL),0)){ const float dl=__builtin_fmaxf(rm,0.f); mhat+=dl; \
        _Pragma("unroll") for(int r=0;r<16;++r){C0[r]-=dl;C1[r]-=dl;} \
        cbm=cb-mhat; \
        const float f=__builtin_amdgcn_exp2f(-dl); l_reg*=f; if(hi==0)wsf[r32]=f; resc=true; } } \
    SBAR(); \
    GAPB(o[0]=__builtin_amdgcn_mfma_f32_32x32x16_bf16(PAF(0),VFR(0),o[0],0,0,0), C0,0); \
    GAPB(o[1]=__builtin_amdgcn_mfma_f32_32x32x16_bf16(PAF(0),VFR(4),o[1],0,0,0), C0,4); \
    KRD(GL,0); GAPB(o[0]=__builtin_amdgcn_mfma_f32_32x32x16_bf16(PAF(1),VFR(1),o[0],0,0,0), C0,8); \
    KRD(GL,1); GAPB(o[1]=__builtin_amdgcn_mfma_f32_32x32x16_bf16(PAF(1),VFR(5),o[1],0,0,0), C0,12); \
    KRD(GL,2); GAPB(o[0]=__builtin_amdgcn_mfma_f32_32x32x16_bf16(PAF(2),VFR(2),o[0],0,0,0), C1,0); \
    KRD(GL,3); GAPB(o[1]=__builtin_amdgcn_mfma_f32_32x32x16_bf16(PAF(2),VFR(6),o[1],0,0,0), C1,4); \
    GAPB(o[0]=__builtin_amdgcn_mfma_f32_32x32x16_bf16(PAF(3),VFR(3),o[0],0,0,0), C1,8); \
    GAPB(o[1]=__builtin_amdgcn_mfma_f32_32x32x16_bf16(PAF(3),VFR(7),o[1],0,0,0), C1,12); \
    }while(0)
  int t=1;
  #undef CMASK
  #define CMASK(P0,P1,t,MW) do{}while(0)
  for(;t+7<NT;t+=2){
    STEP(pB0,pB1,pA0,pA1,t,true,true,true,0,0);     WAIT_BAR(2); RESC(); ROT();
    STEP(pA0,pA1,pB0,pB1,t+1,true,true,true,0,0);   WAIT_BAR(2); RESC(); ROT();
  }
  #undef CMASK
  #define CMASK(P0,P1,t,MW) do{ int jb2_=(t)-(NT-6); if(jb2_>=0)biasadd(P0,P1,tabA,q0+qrel-64*(t),hi); int jb_=(t)-(NT-4); if(jb_>=0)cmask(P0,P1,jb_,qrel,hi);}while(0)
  #define ENDW(tt) do{ if((tt)+3<NT){WAIT_BAR(2);} else if((tt)+2<NT){WAIT_BAR(1);} else {WAIT_BAR(0);} }while(0)
  for(;t+1<NT;t+=2){
    STEP(pB0,pB1,pA0,pA1,t,(t+3<NT),(t+1<NT),(t+1<NT),0,0);       ENDW(t);   RESC(); ROT();
    STEP(pA0,pA1,pB0,pB1,t+1,(t+4<NT),(t+2<NT),(t+2<NT),0,0);     ENDW(t+1); RESC(); ROT();
  }
  STEP(pB0,pB1,pA0,pA1,NT-1,false,false,false,0,0); RESC();
  { float sacc=pB0[0]+pB0[1]; _Pragma("unroll") for(int r=2;r<16;++r)sacc+=pB0[r]; _Pragma("unroll") for(int r=0;r<16;++r)sacc+=pB1[r]; l_reg+=sacc;
    pw0=(u32x4){PKW(pB0,0),PKW(pB0,2),PKW(pB0,4),PKW(pB0,6)};pw1=(u32x4){PKW(pB0,8),PKW(pB0,10),PKW(pB0,12),PKW(pB0,14)};pw2=(u32x4){PKW(pB1,0),PKW(pB1,2),PKW(pB1,4),PKW(pB1,6)};pw3=(u32x4){PKW(pB1,8),PKW(pB1,10),PKW(pB1,12),PKW(pB1,14)};
    SBAR(); pv(o,vb0+sl_cur,PAF(0),PAF(1),PAF(2),PAF(3)); }
  #undef PKW
  #undef PAF
  #undef VFR
  #undef PIN
  #undef MX3
  #undef GAPA
  #undef GAPB
  #undef EX
  #undef VRD
  #undef KRD
  #undef STEP
  #undef ENDW
  {auto rr=__builtin_amdgcn_permlane32_swap(__float_as_uint(l_reg),__float_as_uint(l_reg),false,false);l_reg=__uint_as_float(rr[0])+__uint_as_float(rr[1]);}
  if(hi==0)wsf[32+r32]=l_reg;asm volatile("s_waitcnt lgkmcnt(0)":::"memory");
  float rli[16];
  #pragma unroll
  for(int r=0;r<16;++r)rli[r]=__builtin_amdgcn_rcpf(wsf[32+crow(r,hi)]);
  bf16*Ow=O+(rowbase+q0+wid*QBLK)*DMO+h*D;
  { bf16*stg=(bf16*)(shm+LDS_OST)+wid*2048;
    #pragma unroll
    for(int r=0;r<16;++r){const int orow=crow(r,hi);
      #pragma unroll
      for(int d0=0;d0<2;++d0)stg[orow*64+d0*32+r32]=__float2bfloat16(o[d0][r]*rli[r]);}
    asm volatile("s_waitcnt lgkmcnt(0)":::"memory");
    #pragma unroll
    for(int i=0;i<4;++i){const int row=i*8+(lane>>3),ch=lane&7; const u32x4 v=*(const u32x4*)(stg+row*64+ch*8); ATTN_STORE16(Ow+(long)row*DMO+ch*8,v);} }
  asm volatile("s_waitcnt lgkmcnt(0)\n\ts_barrier":::"memory");
  #undef DMA_K
  #undef MROW
  #undef DMA_V
  #undef CMASK
  #undef START
  #undef RESC
  #undef ROT
}
constexpr int ATTN_LDS_BYTES=LDS_BYTES;
struct AttnTensors { const bf16* Q; const bf16* K; const bf16* V; bf16* O; const unsigned char* MSK; };
struct AttnUnit { int bh; int qb; };
struct StaticOrder {
  int vcu;
  __device__ __forceinline__ explicit StaticOrder(int grid,int block):vcu((block%8)*(grid/8)+block/8){}
  __device__ __forceinline__ bool next(int i,AttnUnit&u)const{ if(i>=2||vcu>=256)return false; const int s=vcu&15; u.bh=vcu>>4; u.qb=(i==0)?s:31-s; return true; }
  __device__ __forceinline__ void a_ready(const AttnUnit&)const{}
  __device__ __forceinline__ void done(const AttnUnit&)const{}
};
template<class Sched,int THRL=8> __device__ __forceinline__ void attn_phase(char*lds,int tid_in,const AttnTensors&T,const Sched&S,const __attribute__((address_space(3))) float*tabA,const __attribute__((address_space(3))) float*cbA){
  AttnUnit u;
  for(int i=0;S.next(i,u);++i){ S.a_ready(u); const int h_=u.bh%NHEAD; attn_unit<THRL>(u.bh/NHEAD,h_,u.qb,T.Q,T.K,T.V,T.O,lds,tid_in,T.MSK,tabA+h_*132,__builtin_bit_cast(float,__builtin_amdgcn_readfirstlane(__builtin_bit_cast(int,cbA[h_])))); S.done(u); }
}
#undef SBAR
#undef WAIT_BAR
}
constexpr int NTOK = 16384, DMOD = 1024, SEQL = 8192, PP = 5120, NLAYER = 2;
constexpr float DN_ALPHA = 1.4142135623730951f;
constexpr float LN_EPS_ = 1e-5f, RMS_EPS_ = 1e-6f;
constexpr float LOG2E = 1.4426950408889634f;
constexpr int MOE_MAXSLOT = 40960, MOE_MAXBLK = 160;
constexpr int PC_AQ = 0, PC_AK = 512, PC_AV = 1024, PC_IQ = 1536, PC_IK = 2048, PC_IW = 2112, PC_BQ = 2304, PC_BI = 3328, PC_BG = 3840, PC_CQ = 4352, PC_CK = 4864, PC_CV = 4992;

constexpr size_t MiB = 1u << 20;
constexpr size_t WS_CTL = 0, WS_FF = 1 * MiB;
constexpr size_t WS_WIN = 2 * MiB, WS_WBR = 34 * MiB, WS_WOUT = 40 * MiB, WS_XWQ = 44 * MiB, WS_XWKV = 48 * MiB, WS_XWO = 56 * MiB;
constexpr size_t WS_MEMB = 60 * MiB, WS_XK = 61 * MiB, WS_XVT = 63 * MiB, WS_MISC = 65 * MiB;
constexpr size_t MISC_LB = 0, MISC_WR = 8192, MISC_EXPI = 512 * 1024, MISC_GW = 768 * 1024, MISC_BLKE = 1024 * 1024, MISC_PCNT = 1024 * 1024 + 8192;
constexpr size_t WS_HB = 68 * MiB;
constexpr size_t WS_P = 100 * MiB;
constexpr size_t WS_T = WS_P, WS_XQ = WS_P + 64 * MiB, WS_XO = WS_P + 96 * MiB, WS_XS = WS_P, WS_HID = WS_P + 80 * MiB;
constexpr size_t WS_Q = 260 * MiB;
constexpr size_t WS_YA = WS_Q, WS_YB = WS_Q + 16 * MiB, WS_YC = WS_Q + 32 * MiB, WS_SC = WS_Q + 48 * MiB, WS_MSK = WS_Q + 178 * MiB, WS_LOGF = WS_Q + 194 * MiB;
constexpr size_t WS_HGL = WS_Q + 226 * MiB, WS_HGS = WS_Q + 242 * MiB, WS_HGD = WS_Q + 258 * MiB, WS_CVT = WS_Q + 259 * MiB, WS_END = WS_Q + 263 * MiB;
constexpr size_t WS_GATE = WS_SC, WS_MERGED = WS_SC + 96 * MiB, WS_MRG = WS_MSK;
constexpr size_t WS_MW13 = WS_SC, WS_MW2 = WS_SC + 64 * MiB, WS_YASG = WS_SC + 96 * MiB;
constexpr size_t SC_BATCH = (size_t)128 * 128 * 2080;
constexpr int CW_TMO = 0, CW_BAR = 4096, CW_CNT = 8192, CW_CUR = 8192 + 256, CW_NBLK = 8192 + 512;

constexpr int LDS_BYTES = 163840, LDS_PERS = 148480;
constexpr int LP_MISC = LDS_PERS, LP_TABA = LDS_PERS + 256, LP_TABC = LP_TABA + 8 * 132 * 4, LP_CBA = LP_TABC + 8 * 128 * 4, LP_SINK = LP_CBA + 32, LP_PTRS = LP_SINK + 64, LP_END = LP_PTRS + 21 * 8;
static_assert(LP_END <= LDS_BYTES, "LDS map");

#define GAS __attribute__((address_space(1)))
#define LAS __attribute__((address_space(3)))
typedef unsigned short bf16;
typedef unsigned v4u __attribute__((ext_vector_type(4)));
typedef unsigned v2u __attribute__((ext_vector_type(2)));
typedef float f32x4 __attribute__((ext_vector_type(4)));
typedef float f32x16 __attribute__((ext_vector_type(16)));
typedef short bf16x8 __attribute__((ext_vector_type(8)));
typedef short s16x4 __attribute__((ext_vector_type(4)));
typedef GAS unsigned gu32;
#define RLX_AGENT __ATOMIC_RELAXED, __HIP_MEMORY_SCOPE_AGENT
#define LDS_WAIT() asm volatile("s_waitcnt lgkmcnt(0)" ::: "memory")
__device__ __forceinline__ unsigned f2bf(float f) { unsigned u = __builtin_bit_cast(unsigned, f); return (u + 0x7fffu + ((u >> 16) & 1u)) >> 16; }
__device__ __forceinline__ unsigned pk2(float lo, float hi) { return f2bf(lo) | (f2bf(hi) << 16); }
__device__ __forceinline__ float bf2f(unsigned short b) { return __uint_as_float((unsigned)b << 16); }
__device__ __forceinline__ float bflo(unsigned w) { return __uint_as_float(w << 16); }
__device__ __forceinline__ float bfhi(unsigned w) { return __uint_as_float(w & 0xffff0000u); }
__device__ __forceinline__ int crow16(int r, int hi) { return (r & 3) + 8 * (r >> 2) + 4 * hi; }
__device__ __forceinline__ bf16x8 cat44(s16x4 a, s16x4 b) { return (bf16x8){a[0], a[1], a[2], a[3], b[0], b[1], b[2], b[3]}; }
__device__ __forceinline__ float xhalf_max(float v) { auto rr = __builtin_amdgcn_permlane32_swap(__float_as_uint(v), __float_as_uint(v), false, false); return fmaxf(__uint_as_float(rr[0]), __uint_as_float(rr[1])); }
__device__ __forceinline__ float xhalf_sum(float v) { auto rr = __builtin_amdgcn_permlane32_swap(__float_as_uint(v), __float_as_uint(v), false, false); return __uint_as_float(rr[0]) + __uint_as_float(rr[1]); }
__device__ __forceinline__ int dpp_row_sum_i(int v) {
    v += __builtin_amdgcn_update_dpp(0, v, 0xB1, 0xF, 0xF, true);
    v += __builtin_amdgcn_update_dpp(0, v, 0x4E, 0xF, 0xF, true);
    v += __builtin_amdgcn_update_dpp(0, v, 0x141, 0xF, 0xF, true);
    v += __builtin_amdgcn_update_dpp(0, v, 0x140, 0xF, 0xF, true);
    return v;
}
__device__ __forceinline__ float dpp_row_sum_f(float v) {
    v += __builtin_bit_cast(float, __builtin_amdgcn_update_dpp(0, __builtin_bit_cast(int, v), 0xB1, 0xF, 0xF, true));
    v += __builtin_bit_cast(float, __builtin_amdgcn_update_dpp(0, __builtin_bit_cast(int, v), 0x4E, 0xF, 0xF, true));
    v += __builtin_bit_cast(float, __builtin_amdgcn_update_dpp(0, __builtin_bit_cast(int, v), 0x141, 0xF, 0xF, true));
    v += __builtin_bit_cast(float, __builtin_amdgcn_update_dpp(0, __builtin_bit_cast(int, v), 0x140, 0xF, 0xF, true));
    return v;
}
__device__ __forceinline__ int wave_sum_i(int v) {
    v = dpp_row_sum_i(v);
    v += __builtin_amdgcn_update_dpp(0, v, 0x142, 0xA, 0xF, false);
    v += __builtin_amdgcn_update_dpp(0, v, 0x143, 0xC, 0xF, false);
    return __builtin_amdgcn_readlane(v, 63);
}
__device__ __forceinline__ float wave_sum(float v) {
    v = dpp_row_sum_f(v);
    v += __builtin_bit_cast(float, __builtin_amdgcn_update_dpp(0, __builtin_bit_cast(int, v), 0x142, 0xA, 0xF, false));
    v += __builtin_bit_cast(float, __builtin_amdgcn_update_dpp(0, __builtin_bit_cast(int, v), 0x143, 0xC, 0xF, false));
    return __builtin_bit_cast(float, __builtin_amdgcn_readlane(__builtin_bit_cast(int, v), 63));
}
#define MFMA32(a, b, c) __builtin_amdgcn_mfma_f32_32x32x16_bf16((a), (b), (c), 0, 0, 0)
#define XB_TMO      128
#define XB_XCNT(j)  (256  + 64 * (j))
#define XB_XSUB(j)  (1280 + 64 * (j))
#define XB_XGEN(j)  (2304 + 64 * (j))
#define XB_TOP      3328
#define XB_TOPGEN   3392
#define XCD_BAR_WORDS 3456
#define XB_SPIN_CAP (1u << 18)

__device__ __forceinline__ unsigned xb_ld(unsigned* p)              { return __hip_atomic_load(p, __ATOMIC_RELAXED, __HIP_MEMORY_SCOPE_AGENT); }
__device__ __forceinline__ unsigned xb_add(unsigned* p, unsigned v) { return __hip_atomic_fetch_add(p, v, __ATOMIC_RELAXED, __HIP_MEMORY_SCOPE_AGENT); }
__device__ __forceinline__ unsigned xb_xcc_id() { return (unsigned)__builtin_amdgcn_s_getreg((3 << 11) | 20) & 0xFu; }
#define XB_SPIN(cond, bar) do { unsigned _sp = 0; while (cond) { __builtin_amdgcn_s_sleep(1); \
    if ((++_sp & 255u) == 0u) { if (xb_ld(&(bar)[XB_TMO])) break; if (_sp > XB_SPIN_CAP) { atomicAdd(&(bar)[XB_TMO], 1u); break; } } } } while (0)

struct XcdBarrier {
    unsigned* bar; unsigned x;
    volatile LAS unsigned* st;
};

__device__ __forceinline__ XcdBarrier xcd_barrier_post(unsigned* bar, volatile LAS unsigned* st) {
    XcdBarrier b; b.bar = bar; b.x = xb_xcc_id(); b.st = st;
    if (threadIdx.x == 0) (void)xb_add(&bar[XB_XCNT(b.x)], 1u);
    return b;
}
__device__ __forceinline__ void xcd_barrier_complete(unsigned* bar, unsigned x, unsigned& nloc, unsigned& nx) {
    const unsigned G = gridDim.x * gridDim.y * gridDim.z;
    unsigned sum, cnt, mine, sp = 0u;
    for (;;) {
        sum = 0u; cnt = 0u; mine = 0u;
#pragma unroll
        for (unsigned j = 0; j < 16; ++j) { const unsigned c = xb_ld(&bar[XB_XCNT(j)]); sum += c; cnt += (c > 0u) ? 1u : 0u; mine = (j == x) ? c : mine; }
        if (sum == G) break;
        __builtin_amdgcn_s_sleep(1);
        if ((++sp & 255u) == 0u) { if (xb_ld(&bar[XB_TMO])) break; if (sp > XB_SPIN_CAP) { atomicAdd(&bar[XB_TMO], 1u); break; } }
    }
    nloc = mine > 0u ? mine : 1u; nx = cnt > 0u ? cnt : 1u;
}

__device__ __noinline__ void xcd_barrier(const XcdBarrier b, const bool leader) {
    asm volatile("s_waitcnt vmcnt(0)" ::: "memory");
    __syncthreads();
    if (leader) {
        unsigned* bar = b.bar;
        __builtin_amdgcn_s_waitcnt(0);
        unsigned nloc = b.st[0], nx = b.st[1];
        if (nloc == 0u) { xcd_barrier_complete(bar, b.x, nloc, nx); b.st[0] = nloc; b.st[1] = nx; }
        const unsigned old = xb_add(&bar[XB_XSUB(b.x)], 1u);
        const unsigned gen = old / nloc;
        if (old + 1u == (gen + 1u) * nloc) {
            __builtin_amdgcn_fence(__ATOMIC_RELEASE, "agent");
            asm volatile("s_waitcnt vmcnt(0)" ::: "memory");
            const unsigned og = xb_add(&bar[XB_TOP], 1u);
            const unsigned tg = og / nx;
            if (og + 1u == (tg + 1u) * nx) xb_add(&bar[XB_TOPGEN], 1u);
            else XB_SPIN(xb_ld(&bar[XB_TOPGEN]) == tg, bar);
            __builtin_amdgcn_fence(__ATOMIC_ACQUIRE, "agent");
            xb_add(&bar[XB_XGEN(b.x)], 1u);
            asm volatile("s_waitcnt vmcnt(0)" ::: "memory");
        } else {
            XB_SPIN(xb_ld(&bar[XB_XGEN(b.x)]) == gen, bar);
            __builtin_amdgcn_fence(__ATOMIC_ACQUIRE, "agent");
            asm volatile("s_waitcnt vmcnt(0)" ::: "memory");
        }
    }
    __syncthreads();
}
struct Frame {
    LAS unsigned char* lds;
    gu32* ctl;
    unsigned char* ws;
    int tid, lane, wave, wave0, vcu, G;
    struct InTab { const LAS unsigned* p;
        __device__ __forceinline__ const float* operator[](int i) const { const unsigned lo = (unsigned)__builtin_amdgcn_readfirstlane((int)p[2 * i]), hi = (unsigned)__builtin_amdgcn_readfirstlane((int)p[2 * i + 1]);
            return (const float*)(const GAS float*)(((unsigned long long)hi << 32) | (unsigned long long)lo); } } in;
    float* out;
};
enum { I_X = 0, I_MEM, I_RELB, I_WIN, I_WBR, I_WOUT, I_LB, I_NG, I_SINK, I_XWQ, I_XWKV, I_XWO, I_WG, I_BG, I_WE, I_BE, I_W1, I_W3, I_W2, I_LNG, I_LNB };

__device__ __forceinline__ unsigned long long launder64(unsigned long long v) { int lo = __builtin_amdgcn_readfirstlane((int)(unsigned)v), hi = __builtin_amdgcn_readfirstlane((int)(unsigned)(v >> 32)); asm volatile("" : "+s"(lo), "+s"(hi)); return ((unsigned long long)(unsigned)hi << 32) | (unsigned)lo; }
#define PHASE_ENTER(F) do { (F).ws = (unsigned char*)(GAS unsigned char*)launder64((unsigned long long)(F).ws); (F).out = (float*)(GAS float*)launder64((unsigned long long)(F).out); (F).ctl = (gu32*)((F).ws + WS_CTL); \
    (F).lane = lane_now(); (F).wave = __builtin_amdgcn_readfirstlane((F).wave0); (F).tid = (F).wave * 64 + (F).lane; } while (0)
__device__ __forceinline__ void tr_item(const float* W, int K, int N, bf16* WT, int kb, int nb, int rowbase, int thresh, int add, LAS float* scr, int lane) {
    const int k0 = 64 * kb, n0 = 32 * nb; const int ncol = n0 + (lane & 31);
#pragma unroll 8
    for (int i = 0; i < 32; ++i) { const int kk = 2 * i + (lane >> 5); scr[kk * 33 + (lane & 31)] = (ncol < N) ? W[(size_t)(k0 + kk) * N + ncol] : 0.f; }
    LDS_WAIT(); asm volatile("" ::: "memory");
    const int c = lane & 7;
#pragma unroll
    for (int j = 0; j < 4; ++j) { const int n = (lane >> 3) + 8 * j; const LAS float* s = scr + (8 * c) * 33 + n; const int o = n0 + n;
        v4u w; w.x = pk2(s[0 * 33], s[1 * 33]); w.y = pk2(s[2 * 33], s[3 * 33]); w.z = pk2(s[4 * 33], s[5 * 33]); w.w = pk2(s[6 * 33], s[7 * 33]);
        if (o < N) *(GAS v4u*)(WT + (size_t)(rowbase + o + (o >= thresh ? add : 0)) * K + k0 + 8 * c) = w; }
    LDS_WAIT(); asm volatile("" ::: "memory");
}
__device__ __forceinline__ void cvt_rows(Frame& F, const float* src, bf16* dst, size_t n8) {
    const size_t gt = (size_t)F.vcu * 512 + F.tid, NT = (size_t)F.G * 512;
    for (size_t i = gt; i < n8; i += NT) { const f32x4 a = *(const GAS f32x4*)(src + i * 8), b = *(const GAS f32x4*)(src + i * 8 + 4);
        v4u w; w.x = pk2(a.x, a.y); w.y = pk2(a.z, a.w); w.z = pk2(b.x, b.y); w.w = pk2(b.z, b.w); *(GAS v4u*)(dst + i * 8) = w; }
}
__device__ __forceinline__ void ph_prologue(Frame& F) {
    LAS float* scr = (LAS float*)(F.lds + F.wave * 16384);
    const int gw = F.vcu * 8 + F.wave, NGW = F.G * 8;
    constexpr int I_IN = 16 * 251, I_BR = 8 * 32, I_SQ = 16 * 32, I_KV = 16 * 64;
    constexpr int PER_L = I_IN + 3 * I_BR + I_SQ + I_SQ + I_KV + I_SQ;
    for (int it = gw; it < 2 * PER_L; it += NGW) {
        const int l = it / PER_L; int r = it % PER_L;
        if (r < I_IN) { tr_item(F.in[I_WIN] + (size_t)l * 1024 * 8008, 1024, 8008, (bf16*)(F.ws + WS_WIN) + (size_t)l * 8192 * 1024, r / 251, r % 251, 0, 2120, 184, scr, F.lane); continue; } r -= I_IN;
        if (r < 3 * I_BR) { const int g = r / I_BR, q = r % I_BR; tr_item(F.in[I_WBR] + (size_t)(l * 3 + g) * 512 * 1024, 512, 1024, (bf16*)(F.ws + WS_WBR) + (size_t)(l * 3 + g) * 1024 * 512, q / 32, q % 32, 0, 1 << 30, 0, scr, F.lane); continue; } r -= 3 * I_BR;
        if (r < I_SQ) { tr_item(F.in[I_WOUT] + (size_t)l * 1024 * 1024, 1024, 1024, (bf16*)(F.ws + WS_WOUT) + (size_t)l * 1024 * 1024, r / 32, r % 32, 0, 1 << 30, 0, scr, F.lane); continue; } r -= I_SQ;
        if (r < I_SQ) { tr_item(F.in[I_XWQ] + (size_t)l * 1024 * 1024, 1024, 1024, (bf16*)(F.ws + WS_XWQ) + (size_t)l * 1024 * 1024, r / 32, r % 32, 0, 1 << 30, 0, scr, F.lane); continue; } r -= I_SQ;
        if (r < I_KV) { tr_item(F.in[I_XWKV] + (size_t)l * 1024 * 2048, 1024, 2048, (bf16*)(F.ws + WS_XWKV) + (size_t)l * 2048 * 1024, r / 64, r % 64, 0, 1 << 30, 0, scr, F.lane); continue; } r -= I_KV;
        tr_item(F.in[I_XWO] + (size_t)l * 1024 * 1024, 1024, 1024, (bf16*)(F.ws + WS_XWO) + (size_t)l * 1024 * 1024, r / 32, r % 32, 0, 1 << 30, 0, scr, F.lane);
    }
    { const size_t gt = (size_t)F.vcu * 512 + F.tid, NT = (size_t)F.G * 512; constexpr size_t PADV = (size_t)184 * 1024 / 8;
      for (size_t i = gt; i < 2 * PADV; i += NT) { const size_t l = i / PADV, j = i % PADV; *(GAS v4u*)((bf16*)(F.ws + WS_WIN) + l * 8192 * 1024 + (size_t)2120 * 1024 + j * 8) = (v4u){0u, 0u, 0u, 0u}; } }
    { const int gt = F.vcu * 512 + F.tid, NT = F.G * 512; int* SA = (int*)(F.ws + WS_FF); for (int i = gt; i < 2 * MOE_MAXSLOT; i += NT) SA[i] = -1; }
    cvt_rows(F, F.in[I_X], (bf16*)(F.ws + WS_HB), (size_t)NTOK * DMOD / 8);
    cvt_rows(F, F.in[I_MEM], (bf16*)(F.ws + WS_MEMB), (size_t)512 * 1024 / 8);
    { const int gt = F.vcu * 512 + F.tid, NT = F.G * 512; float* LB = (float*)(F.ws + WS_MISC + MISC_LB);
      for (int c = gt; c < 512; c += NT) { const float v0 = F.in[I_LB][c], v1 = F.in[I_LB][512 + c], m = fmaxf(v0, v1), e0 = expf(v0 - m), e1 = expf(v1 - m); const float s1 = e1 / (e0 + e1);
          LB[c] = 1e-30f; LB[512 + c] = fminf(fmaxf(s1, 1e-30f), 1.0f - 1e-6f); }
      float* WR = (float*)(F.ws + WS_MISC + MISC_WR);
      for (int i = gt; i < 2 * 36 * 1024; i += NT) { const int l = i / (36 * 1024), r = i % (36 * 1024), n = r / 1024, k = r % 1024;
          WR[(size_t)(l * 36 + n) * 1028 + k] = (n < 4) ? F.in[I_WG][(size_t)l * 1024 * 4 + k * 4 + n] : F.in[I_WE][(size_t)l * 1024 * 32 + k * 32 + (n - 4)]; } }
}
__device__ __forceinline__ void ph_moe_convert(Frame& F, int l) {
    LAS float* scr = (LAS float*)(F.lds + F.wave * 16384);
    const int gw = F.vcu * 8 + F.wave, NGW = F.G * 8;
    bf16* W13 = (bf16*)(F.ws + WS_MW13); bf16* W2 = (bf16*)(F.ws + WS_MW2);
    for (int it = gw; it < 32 * 768; it += NGW) {
        const int e = it / 768; int r = it % 768;
        if (r < 512) { const int w3 = r >> 8, q = r & 255, kb = q / 16, nb = q % 16, n0 = 32 * nb;
            const float* W = F.in[w3 ? I_W3 : I_W1] + ((size_t)l * 32 + e) * 1024 * 512;
            tr_item(W, 1024, 512, W13, kb, nb, e * 1024 + 256 * (n0 >> 7) + 128 * w3 + (n0 & 127) - n0, 1 << 30, 0, scr, F.lane); }
        else { const int q = r - 512, kb = q / 32, nb = q % 32;
            tr_item(F.in[I_W2] + ((size_t)l * 32 + e) * 512 * 1024, 512, 1024, W2, kb, nb, e * 1024, 1 << 30, 0, scr, F.lane); }
    }
}

template <int MODE> __device__ __forceinline__ void ph_ln(Frame& F, int l, int which, const float* Hin) {
    const float* lng = F.in[I_LNG] + (size_t)(l * 3 + which) * 1024; const float* lnb = F.in[I_LNB] + (size_t)(l * 3 + which) * 1024;
    const float* T = (const float*)(F.ws + WS_T); bf16* HB = (bf16*)(F.ws + WS_HB);
    LAS float* WRL = (LAS float*)F.lds; LAS unsigned* LCNT = (LAS unsigned*)(F.lds + 148032);
    if (MODE == 1) {
        const float* WR = (const float*)(F.ws + WS_MISC + MISC_WR) + (size_t)l * 36 * 1028;
        for (int i = F.tid; i < 36 * 1028 / 4; i += 512) ((LAS f32x4*)WRL)[i] = ((const GAS f32x4*)WR)[i];
        if (F.tid < 32) LCNT[F.tid] = 0u;
        __syncthreads();
    }
    f32x4 gv[4], bv[4];
#pragma unroll
    for (int j = 0; j < 4; ++j) { gv[j] = *(const GAS f32x4*)(lng + 256 * j + 4 * F.lane); bv[j] = *(const GAS f32x4*)(lnb + 256 * j + 4 * F.lane); }
    float rbias = 0.f;
    if (MODE == 1) rbias = (F.lane < 4) ? F.in[I_BG][l * 4 + F.lane] : ((F.lane < 36) ? F.in[I_BE][l * 32 + F.lane - 4] : 0.f);
    const int gw = F.vcu * 8 + F.wave, NGW = F.G * 8;
    for (int m0 = gw * 4; m0 < NTOK; m0 += NGW * 4) {
        f32x4 v[4][4];
#pragma unroll
        for (int r = 0; r < 4; ++r) { const size_t row = (size_t)(m0 + r);
            if (MODE == 2) {
                const float* gwp = (const float*)(F.ws + WS_MISC + MISC_GW) + row * 2; const float g0 = gwp[0], g1 = gwp[1];
                const bf16* y0 = (const bf16*)(F.ws + WS_YASG) + row * 2 * 1024, *y1 = y0 + 1024;
#pragma unroll
                for (int j = 0; j < 4; ++j) { const f32x4 hv = *(const GAS f32x4*)(Hin + row * 1024 + 256 * j + 4 * F.lane);
                    const v2u a = *(const GAS v2u*)(y0 + 256 * j + 4 * F.lane), b = *(const GAS v2u*)(y1 + 256 * j + 4 * F.lane);
                    v[r][j].x = DN_ALPHA * hv.x + g0 * bflo(a.x) + g1 * bflo(b.x); v[r][j].y = DN_ALPHA * hv.y + g0 * bfhi(a.x) + g1 * bfhi(b.x);
                    v[r][j].z = DN_ALPHA * hv.z + g0 * bflo(a.y) + g1 * bflo(b.y); v[r][j].w = DN_ALPHA * hv.w + g0 * bfhi(a.y) + g1 * bfhi(b.y); }
            } else {
#pragma unroll
                for (int j = 0; j < 4; ++j) v[r][j] = *(const GAS f32x4*)(T + row * 1024 + 256 * j + 4 * F.lane);
            }
            float s = 0.f;
#pragma unroll
            for (int j = 0; j < 4; ++j) s += (v[r][j].x + v[r][j].y) + (v[r][j].z + v[r][j].w);
            const float mean = wave_sum(s) * (1.f / 1024.f); float s2 = 0.f;
#pragma unroll
            for (int j = 0; j < 4; ++j) { v[r][j] = v[r][j] - mean; s2 += (v[r][j].x * v[r][j].x + v[r][j].y * v[r][j].y) + (v[r][j].z * v[r][j].z + v[r][j].w * v[r][j].w); }
            const float rstd = 1.f / sqrtf(wave_sum(s2) * (1.f / 1024.f) + LN_EPS_);
#pragma unroll
            for (int j = 0; j < 4; ++j) { v[r][j] = v[r][j] * rstd * gv[j] + bv[j];
                *(GAS f32x4*)(F.out + row * 1024 + 256 * j + 4 * F.lane) = v[r][j];
                v2u w; w.x = pk2(v[r][j].x, v[r][j].y); w.y = pk2(v[r][j].z, v[r][j].w); *(GAS v2u*)(HB + row * 1024 + 256 * j + 4 * F.lane) = w; }
        }
        if (MODE == 1) {
            float lg[4] = {0.f, 0.f, 0.f, 0.f};
#pragma unroll 1
            for (int n = 0; n < 36; ++n) {
                f32x4 wv[4];
#pragma unroll
                for (int j = 0; j < 4; ++j) wv[j] = *(const LAS f32x4*)(WRL + n * 1028 + 256 * j + 4 * F.lane);
#pragma unroll
                for (int r = 0; r < 4; ++r) { float p = 0.f;
#pragma unroll
                    for (int j = 0; j < 4; ++j) p += (v[r][j].x * wv[j].x + v[r][j].y * wv[j].y) + (v[r][j].z * wv[j].z + v[r][j].w * wv[j].w);
                    p = wave_sum(p); lg[r] = (F.lane == n) ? p : lg[r]; }
            }
#pragma unroll
            for (int r = 0; r < 4; ++r) {
                const float x = lg[r] + rbias;
                float gl[4];
#pragma unroll
                for (int i = 0; i < 4; ++i) gl[i] = __int_as_float(__builtin_amdgcn_readlane(__float_as_int(x), i));
                int grp = 0; float gm = gl[0];
#pragma unroll
                for (int i = 1; i < 4; ++i) if (gl[i] > gm) { gm = gl[i]; grp = i; }
                float den = 0.f;
#pragma unroll
                for (int i = 0; i < 4; ++i) den += expf(gl[i] - gm);
                const float pg = 1.0f / den;
                grp = __builtin_amdgcn_readfirstlane(grp);
                float ev[8];
#pragma unroll
                for (int e = 0; e < 8; ++e) ev[e] = __int_as_float(__builtin_amdgcn_readlane(__float_as_int(x), 4 + grp * 8 + e));
                int i1 = 0; float v1 = ev[0];
#pragma unroll
                for (int e = 1; e < 8; ++e) if (ev[e] > v1) { v1 = ev[e]; i1 = e; }
                int i2 = -1; float v2 = -INFINITY;
#pragma unroll
                for (int e = 0; e < 8; ++e) if (e != i1 && ev[e] > v2) { v2 = ev[e]; i2 = e; }
                const float ea = 1.0f / (1.0f + expf(v2 - v1));
                if (F.lane == 0) { const size_t row = (size_t)(m0 + r);
                    int* ex = (int*)(F.ws + WS_MISC + MISC_EXPI) + row * 2; float* gwp = (float*)(F.ws + WS_MISC + MISC_GW) + row * 2;
                    const int e1 = grp * 8 + i1, e2 = grp * 8 + i2;
                    ex[0] = e1; ex[1] = e2; gwp[0] = ea * pg; gwp[1] = (1.0f - ea) * pg;
                    __hip_atomic_fetch_add(LCNT + e1, 1u, __ATOMIC_RELAXED, __HIP_MEMORY_SCOPE_WORKGROUP); __hip_atomic_fetch_add(LCNT + e2, 1u, __ATOMIC_RELAXED, __HIP_MEMORY_SCOPE_WORKGROUP); }
            }
        }
    }
    if (MODE == 1) {
        __syncthreads();
        if (F.tid < 32) ((unsigned*)(F.ws + WS_MISC + MISC_PCNT))[F.vcu * 32 + F.tid] = LCNT[F.tid];
    }
}

__device__ __forceinline__ void ph_slots(Frame& F, int l) {
    LAS int* PADS = (LAS int*)F.lds; LAS int* BASE = (LAS int*)(F.lds + 256); LAS int* EXPL = (LAS int*)(F.lds + 512); LAS int* SLOTOF = (LAS int*)(F.lds + 1024); LAS int* PART = (LAS int*)(F.lds + 2048);
    int* BLKE = (int*)(F.ws + WS_MISC + MISC_BLKE) + l * 256; int* SLOT_ASG = (int*)(F.ws + WS_FF) + l * MOE_MAXSLOT;
    const int* EXPI = (const int*)(F.ws + WS_MISC + MISC_EXPI); const unsigned* PCNT = (const unsigned*)(F.ws + WS_MISC + MISC_PCNT);
    if (F.vcu >= NTOK / 64) return;
    { const int e = F.tid & 31, part = F.tid >> 5; int tot = 0, bas = 0;
#pragma unroll 4
      for (int v = part * 16; v < part * 16 + 16; ++v) { const int c = (int)PCNT[v * 32 + e]; tot += c; bas += (v < F.vcu) ? c : 0; }
      PART[(part * 32 + e) * 2] = tot; PART[(part * 32 + e) * 2 + 1] = bas; }
    __syncthreads();
    if (F.tid < 32) { int tot = 0, bas = 0;
#pragma unroll 1
        for (int q = 0; q < 16; ++q) { tot += PART[(q * 32 + F.tid) * 2]; bas += PART[(q * 32 + F.tid) * 2 + 1]; }
        BASE[F.tid] = bas; EXPL[F.tid] = tot; }
    __syncthreads();
    if (F.tid == 0) { int acc = 0;
#pragma unroll 1
        for (int e = 0; e < 32; ++e) { PADS[e] = acc; acc += ((EXPL[e] + 255) >> 8) << 8; }
        PADS[32] = acc;
        if (blockIdx.x == 0) __hip_atomic_store(F.ctl + CW_NBLK + l * 64, (unsigned)(acc >> 8), RLX_AGENT); }
    __syncthreads();
    if (blockIdx.x == 0 && F.tid < MOE_MAXBLK) { const int s0 = F.tid << 8;
        if (s0 < PADS[32]) { int e = 0;
#pragma unroll 1
            for (int q = 1; q < 32; ++q) if (PADS[q] <= s0) e = q;
            BLKE[F.tid] = e; } }
    __syncthreads();
    int e = 0, tok = 0, k = 0;
    if (F.tid < 128) { const int r = F.tid >> 1; tok = (r < 32) ? 32 * F.vcu + r : 8192 + 32 * F.vcu + (r - 32); k = F.tid & 1; e = EXPI[tok * 2 + k]; EXPL[F.tid] = e; }
    __syncthreads();
    if (F.tid < 128) { int rank = 0;
#pragma unroll 1
        for (int a = 0; a < F.tid; ++a) rank += (EXPL[a] == e) ? 1 : 0;
        const int slot = PADS[e] + BASE[e] + rank; SLOTOF[F.tid] = slot; SLOT_ASG[slot] = tok * 2 + k; }
    __syncthreads();
    for (int a = F.wave; a < 128; a += 8) { const int slot = SLOTOF[a]; const int r = a >> 1; const int tk = (r < 32) ? 32 * F.vcu + r : 8192 + 32 * F.vcu + (r - 32);
        const GAS v4u* src = (const GAS v4u*)((const bf16*)(F.ws + WS_HB) + (size_t)tk * 1024); GAS v4u* dst = (GAS v4u*)((bf16*)(F.ws + WS_XS) + (size_t)slot * 1024);
        dst[F.lane] = src[F.lane]; dst[64 + F.lane] = src[64 + F.lane]; }
}
__device__ __forceinline__ size_t sc_row_off(int b, int t) { const int qb = t >> 7; return (size_t)b * SC_BATCH + (size_t)16384 * (size_t)(qb * (qb + 1) / 2) + (size_t)(t & 127) * (size_t)(128 * (qb + 1)); }
__device__ __forceinline__ void ph_indexer(Frame& F) {
    const bf16* P = (const bf16*)(F.ws + WS_P); unsigned short* SC = (unsigned short*)(F.ws + WS_SC);
    const int r32 = F.lane & 31, hi = F.lane >> 5;
    for (int u = F.vcu; u < 256; u += F.G) {
        const int b = u >> 7, p = u & 127;
#pragma unroll 1
        for (int gi = 0; gi < 2; ++gi) {
            const int g = gi ? 255 - p : p, t0 = 32 * g, t = t0 + r32;
            const bf16* qrow = P + (size_t)(b * SEQL + t) * PP;
            bf16x8 qf[8][4];
#pragma unroll
            for (int h = 0; h < 8; ++h)
#pragma unroll
                for (int ks = 0; ks < 4; ++ks) qf[h][ks] = *(const GAS bf16x8*)(qrow + PC_IQ + h * 64 + ks * 16 + hi * 8);
            float w[8];
            { const v4u ww = *(const GAS v4u*)(qrow + PC_IW); const float sc = 0.35355339059327373f * 0.125f;
              w[0] = bflo(ww.x) * sc; w[1] = bfhi(ww.x) * sc; w[2] = bflo(ww.y) * sc; w[3] = bfhi(ww.y) * sc; w[4] = bflo(ww.z) * sc; w[5] = bfhi(ww.z) * sc; w[6] = bflo(ww.w) * sc; w[7] = bfhi(ww.w) * sc; }
            unsigned short* srow = SC + sc_row_off(b, t);
#pragma unroll 1
            for (int kt = F.wave; kt <= g; kt += 8) {
                const bf16* krow = P + (size_t)(b * SEQL + 32 * kt + r32) * PP + PC_IK + hi * 8;
                bf16x8 kf[4];
#pragma unroll
                for (int ks = 0; ks < 4; ++ks) kf[ks] = *(const GAS bf16x8*)(krow + ks * 16);
                f32x16 sc;
#pragma unroll
                for (int r = 0; r < 16; ++r) sc[r] = 0.f;
#pragma unroll
                for (int h = 0; h < 8; ++h) {
                    f32x16 acc;
#pragma unroll
                    for (int r = 0; r < 16; ++r) acc[r] = 0.f;
#pragma unroll
                    for (int ks = 0; ks < 4; ++ks) acc = MFMA32(kf[ks], qf[h][ks], acc);
#pragma unroll
                    for (int r = 0; r < 16; ++r) sc[r] += w[h] * fmaxf(acc[r], 0.f);
                }
#pragma unroll
                for (int q = 0; q < 4; ++q) { v2u o; o.x = __builtin_bit_cast(unsigned, __builtin_amdgcn_cvt_pkrtz(sc[4 * q], sc[4 * q + 1])); o.y = __builtin_bit_cast(unsigned, __builtin_amdgcn_cvt_pkrtz(sc[4 * q + 2], sc[4 * q + 3]));
                    *(GAS v2u*)(srow + 32 * kt + 8 * q + 4 * hi) = o; }
            }
        }
    }
}

template <int NI> __device__ __forceinline__ void select_row(Frame& F, int b, int t) {
    const unsigned short* srow = (const unsigned short*)(F.ws + WS_SC) + sc_row_off(b, t);
    unsigned char* mrow = (unsigned char*)(F.ws + WS_MSK) + (size_t)(b * SEQL + t) * 1024;
    const int lane = lane_now();
    unsigned k[NI * 8];
#pragma unroll
    for (int i = 0; i < NI; ++i) { const int s0 = 8 * (64 * i + lane), rem = t - s0;
        v4u raw = (v4u){0u, 0u, 0u, 0u};
        if (rem >= 0) raw = *(const GAS v4u*)(srow + s0);
#pragma unroll
        for (int e = 0; e < 8; ++e) { const unsigned wv = (e < 2) ? raw.x : (e < 4) ? raw.y : (e < 6) ? raw.z : raw.w; const unsigned hb = (e & 1) ? (wv >> 16) : (wv & 0xffffu);
            const unsigned key = (hb & 0x8000u) ? (~hb & 0xffffu) : (hb | 0x8000u); k[8 * i + e] = (e <= rem) ? key : 0u; } }
    unsigned T = 1u; bool fast = true;
    if (t + 1 > 256) {
        T = 0u;
#pragma unroll 1
        for (int bit = 15; bit >= 0; --bit) { const unsigned cand = T | (1u << bit); int cnt = 0;
#pragma unroll
            for (int j = 0; j < NI * 8; ++j) cnt += (k[j] >= cand) ? 1 : 0;
            cnt = wave_sum_i(cnt);
            if (cnt >= 256) T = cand; }
        int cge = 0, cgt = 0;
#pragma unroll
        for (int j = 0; j < NI * 8; ++j) { cge += (k[j] >= T) ? 1 : 0; cgt += (k[j] > T) ? 1 : 0; }
        cge = wave_sum_i(cge); cgt = wave_sum_i(cgt);
        const int need = 256 - cgt, neq = cge - cgt;
        if (neq != need) {
            fast = false; int base = 0;
#pragma unroll
            for (int i = 0; i < NI; ++i) { int below = 0, tot = 0;
#pragma unroll
                for (int e = 0; e < 8; ++e) { const unsigned long long em = __ballot(k[8 * i + e] == T);
                    below += (int)__builtin_amdgcn_mbcnt_hi((unsigned)(em >> 32), __builtin_amdgcn_mbcnt_lo((unsigned)em, 0u)); tot += __popcll(em); }
                int rank = base + below; unsigned byte = 0u;
#pragma unroll
                for (int e = 0; e < 8; ++e) { const unsigned kv = k[8 * i + e]; bool sel = kv > T; if (kv == T) { sel = rank < need; ++rank; } byte |= sel ? (1u << e) : 0u; }
                mrow[64 * i + lane] = (unsigned char)byte;
                base += tot; }
        }
    }
    if (fast) {
#pragma unroll
        for (int i = 0; i < NI; ++i) { unsigned byte = 0u;
#pragma unroll
            for (int e = 0; e < 8; ++e) byte |= (k[8 * i + e] >= T) ? (1u << e) : 0u;
            mrow[64 * i + lane] = (unsigned char)byte; }
    }
}
__device__ __forceinline__ void ph_select(Frame& F) {
    const int gw = F.vcu * 8 + F.wave, NGW = F.G * 8;
#pragma unroll 1
    for (int R = gw; R < NTOK; R += NGW) { const int b = R >> 13, t = R & 8191;
        if (t < 1024) select_row<2>(F, b, t); else if (t < 2048) select_row<4>(F, b, t); else if (t < 4096) select_row<8>(F, b, t); else select_row<16>(F, b, t); }
}

__device__ __forceinline__ void ph_swa(Frame& F, int l) {
    const bf16* P = (const bf16*)(F.ws + WS_P); const bf16* CVT = (const bf16*)(F.ws + WS_CVT); bf16* YC = (bf16*)(F.ws + WS_YC);
    const LAS float* TABC = (const LAS float*)(F.lds + LP_TABC); const LAS float* SINK = (const LAS float*)(F.lds + LP_SINK);
    const int r32 = F.lane & 31, hi = F.lane >> 5; const int gw = F.vcu * 8 + F.wave, NGW = F.G * 8;
#pragma unroll 1
    for (int id = gw; id < 4096; id += NGW) {
        const int b = id >> 11, hq = (id >> 8) & 7, g = id & 255, kvh = hq >> 2, t0 = 32 * g;
        const bf16* qrow = P + (size_t)(b * SEQL + t0 + r32) * PP + PC_CQ + hq * 64 + hi * 8;
        bf16x8 qf[4];
#pragma unroll
        for (int ks = 0; ks < 4; ++ks) qf[ks] = *(const GAS bf16x8*)(qrow + ks * 16);
        const float sink2 = SINK[l * 8 + hq];
        f32x16 p[5]; float mx = sink2;
#pragma unroll
        for (int jt = 0; jt < 5; ++jt) { const int kt = g - 4 + jt;
#pragma unroll
            for (int r = 0; r < 16; ++r) p[jt][r] = -INFINITY;
            if (kt >= 0) {
                const bf16* krow = P + (size_t)(b * SEQL + 32 * kt + r32) * PP + PC_CK + kvh * 64 + hi * 8;
                f32x16 acc;
#pragma unroll
                for (int r = 0; r < 16; ++r) acc[r] = 0.f;
#pragma unroll
                for (int ks = 0; ks < 4; ++ks) acc = MFMA32(*(const GAS bf16x8*)(krow + ks * 16), qf[ks], acc);
#pragma unroll
                for (int r = 0; r < 16; ++r) { const int d = 32 * (4 - jt) + r32 - crow16(r, hi); const bool ok = (d >= 0) && (d < 128); const int dc = ok ? d : 0;
                    const float x = acc[r] + TABC[hq * 128 + dc]; p[jt][r] = ok ? x : -INFINITY; mx = fmaxf(mx, p[jt][r]); }
            } }
        mx = xhalf_max(mx);
        float ls = 0.f;
#pragma unroll
        for (int jt = 0; jt < 5; ++jt)
#pragma unroll
            for (int r = 0; r < 16; ++r) { p[jt][r] = __builtin_amdgcn_exp2f(p[jt][r] - mx); ls += p[jt][r]; }
        ls = xhalf_sum(ls) + __builtin_amdgcn_exp2f(sink2 - mx);
        f32x16 o[2];
#pragma unroll
        for (int r = 0; r < 16; ++r) { o[0][r] = 0.f; o[1][r] = 0.f; }
#pragma unroll
        for (int jt = 0; jt < 5; ++jt) { const int kt = g - 4 + jt;
            if (kt >= 0) {
#pragma unroll
                for (int s2 = 0; s2 < 2; ++s2) {
                    v4u pw; pw.x = pk2(p[jt][8 * s2 + 0], p[jt][8 * s2 + 1]); pw.y = pk2(p[jt][8 * s2 + 2], p[jt][8 * s2 + 3]); pw.z = pk2(p[jt][8 * s2 + 4], p[jt][8 * s2 + 5]); pw.w = pk2(p[jt][8 * s2 + 6], p[jt][8 * s2 + 7]);
                    const bf16x8 pf = __builtin_bit_cast(bf16x8, pw);
#pragma unroll
                    for (int dt = 0; dt < 2; ++dt) { const bf16* vp = CVT + ((size_t)(b * 128 + kvh * 64 + 32 * dt + r32)) * 8192 + 32 * kt + 16 * s2 + 4 * hi;
                        const bf16x8 vf = cat44(*(const GAS s16x4*)vp, *(const GAS s16x4*)(vp + 8)); o[dt] = MFMA32(vf, pf, o[dt]); }
                } } }
        const float rl = 1.0f / ls; bf16* orow = YC + (size_t)(b * SEQL + t0 + r32) * 512 + hq * 64;
#pragma unroll
        for (int dt = 0; dt < 2; ++dt)
#pragma unroll
            for (int q = 0; q < 4; ++q) { v2u w; w.x = pk2(o[dt][4 * q] * rl, o[dt][4 * q + 1] * rl); w.y = pk2(o[dt][4 * q + 2] * rl, o[dt][4 * q + 3] * rl);
                *(GAS v2u*)(orow + 32 * dt + 8 * q + 4 * hi) = w; }
    }
}

__device__ __forceinline__ void ph_xattn(Frame& F, int l) {
    const bf16* XQ = (const bf16*)(F.ws + WS_XQ); const bf16* XK = (const bf16*)(F.ws + WS_XK) + (size_t)l * 512 * 1024; const bf16* XVT = (const bf16*)(F.ws + WS_XVT) + (size_t)l * 1024 * 512;
    bf16* XO = (bf16*)(F.ws + WS_XO);
    const int r32 = F.lane & 31, hi = F.lane >> 5; const int gw = F.vcu * 8 + F.wave, NGW = F.G * 8;
#pragma unroll 1
    for (int id = gw; id < 2048; id += NGW) {
        const int b = id >> 10, h = (id >> 8) & 3, g = id & 255, t0 = 32 * g;
        f32x16 p[8];
#pragma unroll
        for (int kt = 0; kt < 8; ++kt)
#pragma unroll
            for (int r = 0; r < 16; ++r) p[kt][r] = 0.f;
        const bf16* qrow = XQ + (size_t)(b * SEQL + t0 + r32) * 1024 + h * 256 + hi * 8;
#pragma unroll
        for (int ks = 0; ks < 16; ++ks) { const bf16x8 qf = *(const GAS bf16x8*)(qrow + ks * 16);
#pragma unroll
            for (int kt = 0; kt < 8; ++kt) p[kt] = MFMA32(*(const GAS bf16x8*)(XK + (size_t)(b * 256 + 32 * kt + r32) * 1024 + h * 256 + ks * 16 + hi * 8), qf, p[kt]); }
        float mx = -INFINITY;
#pragma unroll
        for (int kt = 0; kt < 8; ++kt)
#pragma unroll
            for (int r = 0; r < 16; ++r) mx = fmaxf(mx, p[kt][r]);
        mx = xhalf_max(mx);
        float ls = 0.f; v4u pw[8][2];
#pragma unroll
        for (int kt = 0; kt < 8; ++kt) {
#pragma unroll
            for (int r = 0; r < 16; ++r) { p[kt][r] = __builtin_amdgcn_exp2f(p[kt][r] - mx); ls += p[kt][r]; }
#pragma unroll
            for (int s2 = 0; s2 < 2; ++s2) { pw[kt][s2].x = pk2(p[kt][8 * s2 + 0], p[kt][8 * s2 + 1]); pw[kt][s2].y = pk2(p[kt][8 * s2 + 2], p[kt][8 * s2 + 3]); pw[kt][s2].z = pk2(p[kt][8 * s2 + 4], p[kt][8 * s2 + 5]); pw[kt][s2].w = pk2(p[kt][8 * s2 + 6], p[kt][8 * s2 + 7]); } }
        ls = xhalf_sum(ls); const float rl = 1.0f / ls;
        bf16* orow = XO + (size_t)(b * SEQL + t0 + r32) * 1024 + h * 256;
#pragma unroll 1
        for (int dt = 0; dt < 8; ++dt) {
            f32x16 o;
#pragma unroll
            for (int r = 0; r < 16; ++r) o[r] = 0.f;
            const bf16* vrow = XVT + (size_t)(h * 256 + 32 * dt + r32) * 512 + b * 256 + 4 * hi;
#pragma unroll
            for (int kt = 0; kt < 8; ++kt)
#pragma unroll
                for (int s2 = 0; s2 < 2; ++s2) { const bf16* vp = vrow + 32 * kt + 16 * s2; o = MFMA32(cat44(*(const GAS s16x4*)vp, *(const GAS s16x4*)(vp + 8)), __builtin_bit_cast(bf16x8, pw[kt][s2]), o); }
#pragma unroll
            for (int q = 0; q < 4; ++q) { v2u w; w.x = pk2(o[4 * q] * rl, o[4 * q + 1] * rl); w.y = pk2(o[4 * q + 2] * rl, o[4 * q + 3] * rl); *(GAS v2u*)(orow + 32 * dt + 8 * q + 4 * hi) = w; }
        }
    }
}

constexpr int HQ_QT = 0, HQ_KT = 8704, HQ_KHT = 17408, HQ_VT = 27648, HQ_DEC = 37888, HQ_GT = 38400, HQ_OST = 40448;
template <bool OUT> __device__ __forceinline__ void hgrn_item(Frame& F, int l, int item) {
    const int sc = item & 31, bh = item >> 5, b = bh >> 2, h = bh & 3;
    const bf16* P = (const bf16*)(F.ws + WS_P); const float* LOGF = (const float*)(F.ws + WS_LOGF);
    LAS bf16* QT = (LAS bf16*)(F.lds + HQ_QT); LAS bf16* KT = (LAS bf16*)(F.lds + HQ_KT); LAS bf16* KHT = (LAS bf16*)(F.lds + HQ_KHT); LAS bf16* VT = (LAS bf16*)(F.lds + HQ_VT);
    LAS float* DEC = (LAS float*)(F.lds + HQ_DEC); LAS float* GT = (LAS float*)(F.lds + HQ_GT); LAS float* OST = (LAS float*)(F.lds + HQ_OST);
    const int d = F.tid & 127, sg = F.tid >> 7, r32 = F.lane & 31, hi = F.lane >> 5, dvt = F.wave & 3, half = F.wave >> 2;
    f32x16 S[2];
#pragma unroll
    for (int i = 0; i < 2; ++i)
#pragma unroll
        for (int r = 0; r < 16; ++r) S[i][r] = 0.f;
    if (OUT && sc > 0) { const float* HS = (const float*)(F.ws + WS_HGS) + (size_t)item * 16384;
#pragma unroll
        for (int i = 0; i < 2; ++i)
#pragma unroll
            for (int r = 0; r < 16; ++r) S[i][r] = HS[(32 * (2 * half + i) + crow16(r, hi)) * 128 + 32 * dvt + r32]; }
    float atot = 0.f;
#pragma unroll 1
    for (int c = 0; c < 8; ++c) {
        const size_t tok0 = (size_t)b * SEQL + sc * 256 + c * 32;
        float lf[8], a[8], qs[8]; unsigned short vv[8];
#pragma unroll
        for (int i = 0; i < 8; ++i) { const size_t tk = tok0 + 8 * sg + i; lf[i] = LOGF[tk * 512 + h * 128 + d]; vv[i] = P[tk * PP + PC_BI + h * 128 + d]; if (OUT) qs[i] = bf2f(P[tk * PP + PC_BQ + h * 128 + d]); }
        a[0] = lf[0];
#pragma unroll
        for (int i = 1; i < 8; ++i) a[i] = a[i - 1] + lf[i];
        GT[sg * 128 + d] = a[7];
        __syncthreads();
        float off = 0.f, alast = 0.f;
#pragma unroll
        for (int g = 0; g < 4; ++g) { const float gt = GT[g * 128 + d]; off += (g < sg) ? gt : 0.f; alast += gt; }
        unsigned short khv[8];
#pragma unroll
        for (int i = 0; i < 8; ++i) { const float ai = off + a[i]; const float kk = -expm1f(lf[i]);
            if (OUT) { QT[(8 * sg + i) * 136 + d] = (bf16)f2bf(qs[i] * __expf(ai)); KT[(8 * sg + i) * 136 + d] = (bf16)f2bf(kk * __expf(-ai)); }
            khv[i] = (unsigned short)f2bf(kk * __expf(alast - ai)); }
        { v4u w; w.x = khv[0] | ((unsigned)khv[1] << 16); w.y = khv[2] | ((unsigned)khv[3] << 16); w.z = khv[4] | ((unsigned)khv[5] << 16); w.w = khv[6] | ((unsigned)khv[7] << 16); *(LAS v4u*)(KHT + d * 40 + 8 * sg) = w;
          v4u x; x.x = vv[0] | ((unsigned)vv[1] << 16); x.y = vv[2] | ((unsigned)vv[3] << 16); x.z = vv[4] | ((unsigned)vv[5] << 16); x.w = vv[6] | ((unsigned)vv[7] << 16); *(LAS v4u*)(VT + d * 40 + 8 * sg) = x; }
        if (sg == 0) { DEC[d] = __expf(alast); atot += alast; }
        __syncthreads();
        if (OUT) {
            f32x16 X;
#pragma unroll
            for (int r = 0; r < 16; ++r) X[r] = 0.f;
#pragma unroll
            for (int ks = 0; ks < 8; ++ks) X = MFMA32(*(const LAS bf16x8*)(KT + r32 * 136 + ks * 16 + hi * 8), *(const LAS bf16x8*)(QT + r32 * 136 + ks * 16 + hi * 8), X);
#pragma unroll
            for (int r = 0; r < 16; ++r) X[r] = (crow16(r, hi) <= r32) ? X[r] : 0.f;
            v4u xa;
            if (half == 0) { xa.x = pk2(X[0], X[1]); xa.y = pk2(X[2], X[3]); xa.z = pk2(X[4], X[5]); xa.w = pk2(X[6], X[7]); }
            else { xa.x = pk2(X[8], X[9]); xa.y = pk2(X[10], X[11]); xa.z = pk2(X[12], X[13]); xa.w = pk2(X[14], X[15]); }
            f32x16 Z;
#pragma unroll
            for (int r = 0; r < 16; ++r) Z[r] = 0.f;
            { const LAS bf16* vp = VT + (32 * dvt + r32) * 40 + 16 * half + 4 * hi; Z = MFMA32(__builtin_bit_cast(bf16x8, xa), cat44(*(const LAS s16x4*)vp, *(const LAS s16x4*)(vp + 8)), Z); }
#pragma unroll
            for (int i = 0; i < 2; ++i)
#pragma unroll
                for (int s2 = 0; s2 < 2; ++s2) { v4u sb; sb.x = pk2(S[i][8 * s2 + 0], S[i][8 * s2 + 1]); sb.y = pk2(S[i][8 * s2 + 2], S[i][8 * s2 + 3]); sb.z = pk2(S[i][8 * s2 + 4], S[i][8 * s2 + 5]); sb.w = pk2(S[i][8 * s2 + 6], S[i][8 * s2 + 7]);
                    const LAS bf16* qp = QT + r32 * 136 + 32 * (2 * half + i) + 16 * s2 + 4 * hi; Z = MFMA32(cat44(*(const LAS s16x4*)qp, *(const LAS s16x4*)(qp + 8)), __builtin_bit_cast(bf16x8, sb), Z); }
#pragma unroll
            for (int r = 0; r < 16; ++r) OST[(half * 32 + crow16(r, hi)) * 132 + 32 * dvt + r32] = Z[r];
        }
#pragma unroll
        for (int i = 0; i < 2; ++i) { const int dkt = 2 * half + i;
#pragma unroll
            for (int r = 0; r < 16; ++r) S[i][r] *= DEC[32 * dkt + crow16(r, hi)];
#pragma unroll
            for (int ks = 0; ks < 2; ++ks) S[i] = MFMA32(*(const LAS bf16x8*)(KHT + (32 * dkt + r32) * 40 + 16 * ks + 8 * hi), *(const LAS bf16x8*)(VT + (32 * dvt + r32) * 40 + 16 * ks + 8 * hi), S[i]); }
        if (OUT) {
            __syncthreads();
            const int t = F.tid >> 4, part = F.tid & 15; float o[8]; float ss = 0.f;
#pragma unroll
            for (int j = 0; j < 8; ++j) { o[j] = OST[t * 132 + 8 * part + j] + OST[(32 + t) * 132 + 8 * part + j]; ss += o[j] * o[j]; }
            ss = dpp_row_sum_f(ss);
            const float rinv = 1.0f / sqrtf(ss * (1.0f / 128.0f) + RMS_EPS_);
            const v4u gg = *(const GAS v4u*)(P + (tok0 + t) * PP + PC_BG + h * 128 + 8 * part);
            const float* ng = F.in[I_NG] + (size_t)l * 512 + h * 128 + 8 * part;
            v4u w; w.x = pk2(o[0] * rinv * ng[0] * bflo(gg.x), o[1] * rinv * ng[1] * bfhi(gg.x)); w.y = pk2(o[2] * rinv * ng[2] * bflo(gg.y), o[3] * rinv * ng[3] * bfhi(gg.y));
            w.z = pk2(o[4] * rinv * ng[4] * bflo(gg.z), o[5] * rinv * ng[5] * bfhi(gg.z)); w.w = pk2(o[6] * rinv * ng[6] * bflo(gg.w), o[7] * rinv * ng[7] * bfhi(gg.w));
            *(GAS v4u*)((bf16*)(F.ws + WS_YB) + (tok0 + t) * 512 + h * 128 + 8 * part) = w;
        }
        __syncthreads();
    }
    if (!OUT) { float* HL = (float*)(F.ws + WS_HGL) + (size_t)item * 16384;
#pragma unroll
        for (int i = 0; i < 2; ++i)
#pragma unroll
            for (int r = 0; r < 16; ++r) HL[(32 * (2 * half + i) + crow16(r, hi)) * 128 + 32 * dvt + r32] = S[i][r];
        if (sg == 0) ((float*)(F.ws + WS_HGD))[item * 128 + d] = __expf(atot); }
}
__device__ __forceinline__ void ph_hgrn_scan(Frame& F) {
    const float* HL = (const float*)(F.ws + WS_HGL); const float* HD = (const float*)(F.ws + WS_HGD); float* HS = (float*)(F.ws + WS_HGS);
    for (int e = F.vcu * 512 + F.tid; e < 8 * 16384; e += F.G * 512) { const int bh = e >> 14, el = e & 16383, dk = el >> 7; float s = 0.f;
#pragma unroll 4
        for (int sc = 0; sc < 32; ++sc) { const int item = bh * 32 + sc; HS[(size_t)item * 16384 + el] = s; s = HD[item * 128 + dk] * s + HL[(size_t)item * 16384 + el]; } }
}
struct Args { const float* in[21]; float* out; unsigned char* ws; int ph_lo, ph_hi; };
constexpr int PH_PER_LAYER = 15, PH_TOTAL = 1 + 2 * PH_PER_LAYER;

__device__ __forceinline__ int t5_bucket_dev(int d) {
    if (d < 16) return d;
    int v = 16 + (int)(logf((float)d / 16.0f) / 2.0794415416798357f * 16.0f);
    return v < 31 ? v : 31;
}

__global__ void __launch_bounds__(512, 2) mk_fwd(Args args) {
    extern __shared__ __attribute__((aligned(16))) unsigned char lds[];
    Frame F;
    F.lds = (LAS unsigned char*)lds; F.ws = args.ws; F.ctl = (gu32*)(args.ws + WS_CTL);
    F.tid = threadIdx.x; F.lane = F.tid & 63; F.wave = __builtin_amdgcn_readfirstlane(F.tid >> 6); F.wave0 = F.wave;
    F.G = gridDim.x; { const int bx = blockIdx.x; F.vcu = (F.G % 8 == 0) ? (bx % 8) * (F.G / 8) + bx / 8 : bx; }
    for (int i = F.tid; i < LDS_BYTES / 16; i += 512) ((LAS v4u*)F.lds)[i] = (v4u){0u, 0u, 0u, 0u};
    __syncthreads();
    { LAS unsigned long long* PT = (LAS unsigned long long*)(F.lds + LP_PTRS);
#pragma unroll
      for (int i = 0; i < 21; ++i) if (F.tid == i) PT[i] = (unsigned long long)args.in[i];
      F.in.p = (const LAS unsigned*)(F.lds + LP_PTRS); }
    F.out = args.out;
    __syncthreads();
    volatile LAS unsigned* MISC = (volatile LAS unsigned*)(F.lds + LP_MISC);
    if (F.tid < 64) MISC[F.tid] = 0u;
    { LAS float* TABA = (LAS float*)(F.lds + LP_TABA); LAS float* TABC = (LAS float*)(F.lds + LP_TABC); LAS float* CBA = (LAS float*)(F.lds + LP_CBA); LAS float* SINK = (LAS float*)(F.lds + LP_SINK);
      const float* rb = F.in[I_RELB];
      for (int i = F.tid; i < 8 * 132; i += 512) { const int h = i / 132, d = i % 132; TABA[i] = (d < 128) ? (rb[t5_bucket_dev(d) * 16 + h] - rb[31 * 16 + h]) * LOG2E : 0.f; }
      for (int i = F.tid; i < 8 * 128; i += 512) { const int h = i >> 7, d = i & 127; TABC[i] = rb[t5_bucket_dev(d) * 16 + 8 + h] * LOG2E; }
      if (F.tid < 8) CBA[F.tid] = rb[31 * 16 + F.tid] * LOG2E;
      if (F.tid < 16) SINK[F.tid] = F.in[I_SINK][F.tid] * LOG2E; }
    __syncthreads();
    XcdBarrier bar = xcd_barrier_post((unsigned*)(F.ctl + CW_BAR), MISC + 8);
    const int lo = args.ph_lo, hi = args.ph_hi;
#ifndef PHMASK
#define PHMASK 0xFFFFu
#endif
#define IN(k) (lo <= (k) && (k) < hi)
#define INL(j) (((PHMASK >> (1 + (j))) & 1u) && lo <= (pb + (j)) && (pb + (j)) < hi)
#define SEAM(k) do { if (IN(k) && IN((k) + 1)) { PHASE_ENTER(F); xcd_barrier(bar, F.tid == 0); } } while (0)
    LAS unsigned char* RING = F.lds;

    if ((PHMASK & 1u) && IN(0)) { PHASE_ENTER(F); ph_prologue(F); } SEAM(0);

#pragma unroll 1
    for (int l = 0; l < NLAYER; ++l) {
        const int pb = 1 + PH_PER_LAYER * l;
#define HB ((const bf16*)(F.ws + WS_HB))
#define WIN ((const bf16*)(F.ws + WS_WIN) + (size_t)l * 8192 * 1024)
#define Hres ((l == 0) ? F.in[I_X] : (const float*)F.out)
        if (INL(0)) { PHASE_ENTER(F);
            { pg8::Gemm g{HB, WIN, NTOK, PP, 1024}; pg8::StaticOrder S; S.init(NTOK, PP, F.G, (int)blockIdx.x);
              pg8::EpiProj E{(bf16*)(F.ws + WS_P), (float*)(F.ws + WS_LOGF), (bf16*)(F.ws + WS_CVT), (const float*)(F.ws + WS_MISC + MISC_LB) + l * 512};
              pg8::gemm_phase<pg8::EpiProj, pg8::StaticOrder, true, true>(RING, F.wave, g, S, E); }
            if (l == 0) {
#pragma unroll 1
                for (int q = 0; q < 4; ++q) { const int ll = q >> 1, isv = q & 1;
                    const bf16* MEMB = (const bf16*)(F.ws + WS_MEMB); const bf16* WKV = (const bf16*)(F.ws + WS_XWKV) + (size_t)ll * 2048 * 1024;
                    pg8::Gemm g = isv ? pg8::Gemm{WKV + (size_t)1024 * 1024, MEMB, 1024, 512, 1024} : pg8::Gemm{MEMB, WKV, 512, 1024, 1024};
                    pg8::StaticOrder S; S.init(g.M, g.N, F.G, (int)blockIdx.x);
                    pg8::EpiStore<0> E{isv ? (bf16*)(F.ws + WS_XVT) + (size_t)ll * 1024 * 512 : (bf16*)(F.ws + WS_XK) + (size_t)ll * 512 * 1024, isv ? 512 : 1024, 1.0f};
                    __syncthreads();
                    pg8::gemm_phase<pg8::EpiStore<0>, pg8::StaticOrder, true, true>(RING, F.wave, g, S, E); }
            }
        }
        SEAM(pb + 0);
        if (INL(1)) { PHASE_ENTER(F);
#ifndef SUBM
#define SUBM 7
#endif
            if (SUBM & 1) for (int it = F.vcu; it < 256; it += F.G) hgrn_item<false>(F, l, it);
            PHASE_ENTER(F);
            if (SUBM & 2) ph_indexer(F);
            PHASE_ENTER(F);
            if (SUBM & 4) ph_swa(F, l);
        }
        SEAM(pb + 1);
        if (INL(2)) { PHASE_ENTER(F); if (SUBM & 1) ph_select(F); PHASE_ENTER(F); if (SUBM & 2) ph_hgrn_scan(F); }
        SEAM(pb + 2);
        if (INL(3)) { PHASE_ENTER(F);
            if (SUBM & 1) { const attn_body::AttnTensors AT{(const attn_body::bf16*)(F.ws + WS_P) + PC_AQ, (const attn_body::bf16*)(F.ws + WS_P) + PC_AK, (const attn_body::bf16*)(F.ws + WS_P) + PC_AV, (attn_body::bf16*)(F.ws + WS_YA), (const unsigned char*)(F.ws + WS_MSK)};
              const attn_body::StaticOrder S((int)F.G, (int)blockIdx.x);
              attn_body::attn_phase<attn_body::StaticOrder>((char*)lds, F.wave, AT, S, (const LAS float*)(F.lds + LP_TABA), (const LAS float*)(F.lds + LP_CBA)); }
            __syncthreads(); PHASE_ENTER(F);
            if (SUBM & 2) for (int it = F.vcu; it < 256; it += F.G) hgrn_item<true>(F, l, it);
            __syncthreads(); PHASE_ENTER(F);
            if (SUBM & 4) { pg8::Gemm g{HB, WIN + (size_t)PP * 1024, NTOK, 3072, 1024}; pg8::StaticOrder S; S.init(NTOK, 3072, F.G, (int)blockIdx.x);
              pg8::EpiStore<1> E{(bf16*)(F.ws + WS_GATE), 3072, 1.0f};
              pg8::gemm_phase<pg8::EpiStore<1>, pg8::StaticOrder, true, true>(RING, F.wave, g, S, E); }
        }
        SEAM(pb + 3);
        if (INL(4)) { PHASE_ENTER(F);
#pragma unroll 1
            for (int g3 = 0; g3 < 3; ++g3) {
                pg8::Gemm g{(const bf16*)(F.ws + WS_YA) + (size_t)g3 * NTOK * 512, (const bf16*)(F.ws + WS_WBR) + (size_t)(l * 3 + g3) * 1024 * 512, NTOK, 1024, 512}; pg8::StaticOrder S; S.init(NTOK, 1024, F.G, (int)blockIdx.x);
                pg8::EpiMerge E{(const bf16*)(F.ws + WS_GATE), (float*)(F.ws + WS_MRG), (bf16*)(F.ws + WS_MERGED), g3};
                __syncthreads();
                pg8::gemm_phase<pg8::EpiMerge, pg8::StaticOrder, false, true>(RING, F.wave, g, S, E); }
        }
        SEAM(pb + 4);
        if (INL(5)) { PHASE_ENTER(F);
            pg8::Gemm g{(const bf16*)(F.ws + WS_MERGED), (const bf16*)(F.ws + WS_WOUT) + (size_t)l * 1024 * 1024, NTOK, 1024, 1024}; pg8::StaticOrder S; S.init(NTOK, 1024, F.G, (int)blockIdx.x);
            pg8::EpiResid E{Hres, (float*)(F.ws + WS_T), DN_ALPHA};
            pg8::gemm_phase<pg8::EpiResid, pg8::StaticOrder, false, true>(RING, F.wave, g, S, E);
        }
        SEAM(pb + 5);
        if (INL(6)) { PHASE_ENTER(F); ph_ln<0>(F, l, 0, nullptr); __syncthreads(); PHASE_ENTER(F); ph_moe_convert(F, l); }
        SEAM(pb + 6);
        if (INL(7)) { PHASE_ENTER(F);
            pg8::Gemm g{HB, (const bf16*)(F.ws + WS_XWQ) + (size_t)l * 1024 * 1024, NTOK, 1024, 1024}; pg8::StaticOrder S; S.init(NTOK, 1024, F.G, (int)blockIdx.x);
            pg8::EpiStore<0> E{(bf16*)(F.ws + WS_XQ), 1024, pg8::XQ_C2};
            pg8::gemm_phase<pg8::EpiStore<0>, pg8::StaticOrder, false, true>(RING, F.wave, g, S, E);
        }
        SEAM(pb + 7);
        if (INL(8)) { PHASE_ENTER(F); ph_xattn(F, l); }
        SEAM(pb + 8);
        if (INL(9)) { PHASE_ENTER(F);
            pg8::Gemm g{(const bf16*)(F.ws + WS_XO), (const bf16*)(F.ws + WS_XWO) + (size_t)l * 1024 * 1024, NTOK, 1024, 1024}; pg8::StaticOrder S; S.init(NTOK, 1024, F.G, (int)blockIdx.x);
            pg8::EpiResid E{F.out, (float*)(F.ws + WS_T), DN_ALPHA};
            pg8::gemm_phase<pg8::EpiResid, pg8::StaticOrder, false, true>(RING, F.wave, g, S, E);
        }
        SEAM(pb + 9);
        if (INL(10)) { PHASE_ENTER(F); ph_ln<1>(F, l, 1, nullptr); }
        SEAM(pb + 10);
        if (INL(11)) { PHASE_ENTER(F); ph_slots(F, l); }
        SEAM(pb + 11);
        if (INL(12)) { PHASE_ENTER(F);
            const int nblk = (int)__hip_atomic_load(F.ctl + CW_NBLK + l * 64, RLX_AGENT);
            pg8::Gemm g{(const bf16*)(F.ws + WS_XS), (const bf16*)(F.ws + WS_MW13), MOE_MAXSLOT, 32 * 1024, 1024};
            pg8::MoeOrder S{(const int*)(F.ws + WS_MISC + MISC_BLKE) + l * 256, nblk * 4, F.G, F.vcu};
            pg8::EpiMoeUp E{(bf16*)(F.ws + WS_HID)};
            pg8::gemm_phase<pg8::EpiMoeUp, pg8::MoeOrder, true, true>(RING, F.wave, g, S, E);
        }
        SEAM(pb + 12);
        if (INL(13)) { PHASE_ENTER(F);
            const int nblk = (int)__hip_atomic_load(F.ctl + CW_NBLK + l * 64, RLX_AGENT);
            pg8::Gemm g{(const bf16*)(F.ws + WS_HID), (const bf16*)(F.ws + WS_MW2), MOE_MAXSLOT, 32 * 1024, 512};
            pg8::MoeOrder S{(const int*)(F.ws + WS_MISC + MISC_BLKE) + l * 256, nblk * 4, F.G, F.vcu};
            pg8::EpiMoeDown E{(bf16*)(F.ws + WS_YASG), (const int*)(F.ws + WS_FF) + l * MOE_MAXSLOT};
            pg8::gemm_phase<pg8::EpiMoeDown, pg8::MoeOrder, true, true>(RING, F.wave, g, S, E);
        }
        SEAM(pb + 13);
        if (INL(14)) { PHASE_ENTER(F); ph_ln<2>(F, l, 2, F.out); }
        SEAM(pb + 14);
    }
#ifdef MK_TMOCHK
    { PHASE_ENTER(F); xcd_barrier(bar, F.tid == 0);
      const unsigned tmo = __hip_atomic_load(F.ctl + CW_BAR + XB_TMO, RLX_AGENT);
      if (tmo) { for (size_t i = (size_t)F.vcu * 512 + F.tid; i < (size_t)NTOK * DMOD; i += (size_t)F.G * 512) F.out[i] += 1.0f; } }
#endif
#undef IN
#undef SEAM
}

#ifdef MK_DBL
__global__ void __launch_bounds__(256) cs_kernel(const unsigned* ws, size_t nws, const unsigned* out, size_t nout, unsigned long long* slot) {
    unsigned long long s = 0; const size_t gt = (size_t)blockIdx.x * 256 + threadIdx.x, NT = (size_t)gridDim.x * 256;
    for (size_t i = gt; i < nws; i += NT) s += (unsigned long long)ws[i] * (2 * i + 1);
    for (size_t i = gt; i < nout; i += NT) s += (unsigned long long)out[i] * (2 * (i + nws) + 1);
    for (int o = 32; o > 0; o >>= 1) s += __shfl_xor(s, o);
    if ((threadIdx.x & 63) == 0) atomicAdd(slot, s);
}
__global__ void __launch_bounds__(512, 2) scrub_kernel(unsigned* sink) {
    extern __shared__ __attribute__((aligned(16))) unsigned char sl[];
    for (int i = threadIdx.x; i < 163840 / 4; i += 512) ((unsigned*)sl)[i] = 0x7fc0dead ^ (unsigned)i;
    __syncthreads();
    asm volatile("v_mov_b32 v0, 0x7fc12345\n\tv_mov_b32 v1, 0x7fc12345\n\tv_mov_b32 v2, 0x7fc12345\n\tv_mov_b32 v3, 0x7fc12345\n\tv_mov_b32 v4, 0x7fc12345\n\tv_mov_b32 v5, 0x7fc12345\n\tv_mov_b32 v6, 0x7fc12345\n\tv_mov_b32 v7, 0x7fc12345\n\tv_mov_b32 v8, 0x7fc12345\n\tv_mov_b32 v9, 0x7fc12345\n\tv_mov_b32 v10, 0x7fc12345\n\tv_mov_b32 v11, 0x7fc12345\n\tv_mov_b32 v12, 0x7fc12345\n\tv_mov_b32 v13, 0x7fc12345\n\tv_mov_b32 v14, 0x7fc12345\n\tv_mov_b32 v15, 0x7fc12345\n\tv_mov_b32 v16, 0x7fc12345\n\tv_mov_b32 v17, 0x7fc12345\n\tv_mov_b32 v18, 0x7fc12345\n\tv_mov_b32 v19, 0x7fc12345\n\tv_mov_b32 v20, 0x7fc12345\n\tv_mov_b32 v21, 0x7fc12345\n\tv_mov_b32 v22, 0x7fc12345\n\tv_mov_b32 v23, 0x7fc12345\n\tv_mov_b32 v24, 0x7fc12345\n\tv_mov_b32 v25, 0x7fc12345\n\tv_mov_b32 v26, 0x7fc12345\n\tv_mov_b32 v27, 0x7fc12345\n\tv_mov_b32 v28, 0x7fc12345\n\tv_mov_b32 v29, 0x7fc12345\n\tv_mov_b32 v30, 0x7fc12345\n\tv_mov_b32 v31, 0x7fc12345\n\tv_mov_b32 v32, 0x7fc12345\n\tv_mov_b32 v33, 0x7fc12345\n\tv_mov_b32 v34, 0x7fc12345\n\tv_mov_b32 v35, 0x7fc12345\n\tv_mov_b32 v36, 0x7fc12345\n\tv_mov_b32 v37, 0x7fc12345\n\tv_mov_b32 v38, 0x7fc12345\n\tv_mov_b32 v39, 0x7fc12345\n\tv_mov_b32 v40, 0x7fc12345\n\tv_mov_b32 v41, 0x7fc12345\n\tv_mov_b32 v42, 0x7fc12345\n\tv_mov_b32 v43, 0x7fc12345\n\tv_mov_b32 v44, 0x7fc12345\n\tv_mov_b32 v45, 0x7fc12345\n\tv_mov_b32 v46, 0x7fc12345\n\tv_mov_b32 v47, 0x7fc12345\n\tv_mov_b32 v48, 0x7fc12345\n\tv_mov_b32 v49, 0x7fc12345\n\tv_mov_b32 v50, 0x7fc12345\n\tv_mov_b32 v51, 0x7fc12345\n\tv_mov_b32 v52, 0x7fc12345\n\tv_mov_b32 v53, 0x7fc12345\n\tv_mov_b32 v54, 0x7fc12345\n\tv_mov_b32 v55, 0x7fc12345\n\tv_mov_b32 v56, 0x7fc12345\n\tv_mov_b32 v57, 0x7fc12345\n\tv_mov_b32 v58, 0x7fc12345\n\tv_mov_b32 v59, 0x7fc12345\n\tv_mov_b32 v60, 0x7fc12345\n\tv_mov_b32 v61, 0x7fc12345\n\tv_mov_b32 v62, 0x7fc12345\n\tv_mov_b32 v63, 0x7fc12345\n\tv_mov_b32 v64, 0x7fc12345\n\tv_mov_b32 v65, 0x7fc12345\n\tv_mov_b32 v66, 0x7fc12345\n\tv_mov_b32 v67, 0x7fc12345\n\tv_mov_b32 v68, 0x7fc12345\n\tv_mov_b32 v69, 0x7fc12345\n\tv_mov_b32 v70, 0x7fc12345\n\tv_mov_b32 v71, 0x7fc12345\n\tv_mov_b32 v72, 0x7fc12345\n\tv_mov_b32 v73, 0x7fc12345\n\tv_mov_b32 v74, 0x7fc12345\n\tv_mov_b32 v75, 0x7fc12345\n\tv_mov_b32 v76, 0x7fc12345\n\tv_mov_b32 v77, 0x7fc12345\n\tv_mov_b32 v78, 0x7fc12345\n\tv_mov_b32 v79, 0x7fc12345\n\tv_mov_b32 v80, 0x7fc12345\n\tv_mov_b32 v81, 0x7fc12345\n\tv_mov_b32 v82, 0x7fc12345\n\tv_mov_b32 v83, 0x7fc12345\n\tv_mov_b32 v84, 0x7fc12345\n\tv_mov_b32 v85, 0x7fc12345\n\tv_mov_b32 v86, 0x7fc12345\n\tv_mov_b32 v87, 0x7fc12345\n\tv_mov_b32 v88, 0x7fc12345\n\tv_mov_b32 v89, 0x7fc12345\n\tv_mov_b32 v90, 0x7fc12345\n\tv_mov_b32 v91, 0x7fc12345\n\tv_mov_b32 v92, 0x7fc12345\n\tv_mov_b32 v93, 0x7fc12345\n\tv_mov_b32 v94, 0x7fc12345\n\tv_mov_b32 v95, 0x7fc12345\n\tv_mov_b32 v96, 0x7fc12345\n\tv_mov_b32 v97, 0x7fc12345\n\tv_mov_b32 v98, 0x7fc12345\n\tv_mov_b32 v99, 0x7fc12345\n\tv_mov_b32 v100, 0x7fc12345\n\tv_mov_b32 v101, 0x7fc12345\n\tv_mov_b32 v102, 0x7fc12345\n\tv_mov_b32 v103, 0x7fc12345\n\tv_mov_b32 v104, 0x7fc12345\n\tv_mov_b32 v105, 0x7fc12345\n\tv_mov_b32 v106, 0x7fc12345\n\tv_mov_b32 v107, 0x7fc12345\n\tv_mov_b32 v108, 0x7fc12345\n\tv_mov_b32 v109, 0x7fc12345\n\tv_mov_b32 v110, 0x7fc12345\n\tv_mov_b32 v111, 0x7fc12345\n\tv_mov_b32 v112, 0x7fc12345\n\tv_mov_b32 v113, 0x7fc12345\n\tv_mov_b32 v114, 0x7fc12345\n\tv_mov_b32 v115, 0x7fc12345\n\tv_mov_b32 v116, 0x7fc12345\n\tv_mov_b32 v117, 0x7fc12345\n\tv_mov_b32 v118, 0x7fc12345\n\tv_mov_b32 v119, 0x7fc12345\n\tv_mov_b32 v120, 0x7fc12345\n\tv_mov_b32 v121, 0x7fc12345\n\tv_mov_b32 v122, 0x7fc12345\n\tv_mov_b32 v123, 0x7fc12345\n\tv_mov_b32 v124, 0x7fc12345\n\tv_mov_b32 v125, 0x7fc12345\n\tv_mov_b32 v126, 0x7fc12345\n\tv_mov_b32 v127, 0x7fc12345\n\tv_mov_b32 v128, 0x7fc12345\n\tv_mov_b32 v129, 0x7fc12345\n\tv_mov_b32 v130, 0x7fc12345\n\tv_mov_b32 v131, 0x7fc12345\n\tv_mov_b32 v132, 0x7fc12345\n\tv_mov_b32 v133, 0x7fc12345\n\tv_mov_b32 v134, 0x7fc12345\n\tv_mov_b32 v135, 0x7fc12345\n\tv_mov_b32 v136, 0x7fc12345\n\tv_mov_b32 v137, 0x7fc12345\n\tv_mov_b32 v138, 0x7fc12345\n\tv_mov_b32 v139, 0x7fc12345\n\tv_mov_b32 v140, 0x7fc12345\n\tv_mov_b32 v141, 0x7fc12345\n\tv_mov_b32 v142, 0x7fc12345\n\tv_mov_b32 v143, 0x7fc12345\n\tv_mov_b32 v144, 0x7fc12345\n\tv_mov_b32 v145, 0x7fc12345\n\tv_mov_b32 v146, 0x7fc12345\n\tv_mov_b32 v147, 0x7fc12345\n\tv_mov_b32 v148, 0x7fc12345\n\tv_mov_b32 v149, 0x7fc12345\n\tv_mov_b32 v150, 0x7fc12345\n\tv_mov_b32 v151, 0x7fc12345\n\tv_mov_b32 v152, 0x7fc12345\n\tv_mov_b32 v153, 0x7fc12345\n\tv_mov_b32 v154, 0x7fc12345\n\tv_mov_b32 v155, 0x7fc12345\n\tv_mov_b32 v156, 0x7fc12345\n\tv_mov_b32 v157, 0x7fc12345\n\tv_mov_b32 v158, 0x7fc12345\n\tv_mov_b32 v159, 0x7fc12345\n\tv_mov_b32 v160, 0x7fc12345\n\tv_mov_b32 v161, 0x7fc12345\n\tv_mov_b32 v162, 0x7fc12345\n\tv_mov_b32 v163, 0x7fc12345\n\tv_mov_b32 v164, 0x7fc12345\n\tv_mov_b32 v165, 0x7fc12345\n\tv_mov_b32 v166, 0x7fc12345\n\tv_mov_b32 v167, 0x7fc12345\n\tv_mov_b32 v168, 0x7fc12345\n\tv_mov_b32 v169, 0x7fc12345\n\tv_mov_b32 v170, 0x7fc12345\n\tv_mov_b32 v171, 0x7fc12345\n\tv_mov_b32 v172, 0x7fc12345\n\tv_mov_b32 v173, 0x7fc12345\n\tv_mov_b32 v174, 0x7fc12345\n\tv_mov_b32 v175, 0x7fc12345\n\tv_mov_b32 v176, 0x7fc12345\n\tv_mov_b32 v177, 0x7fc12345\n\tv_mov_b32 v178, 0x7fc12345\n\tv_mov_b32 v179, 0x7fc12345\n\tv_mov_b32 v180, 0x7fc12345\n\tv_mov_b32 v181, 0x7fc12345\n\tv_mov_b32 v182, 0x7fc12345\n\tv_mov_b32 v183, 0x7fc12345\n\tv_mov_b32 v184, 0x7fc12345\n\tv_mov_b32 v185, 0x7fc12345\n\tv_mov_b32 v186, 0x7fc12345\n\tv_mov_b32 v187, 0x7fc12345\n\tv_mov_b32 v188, 0x7fc12345\n\tv_mov_b32 v189, 0x7fc12345\n\tv_mov_b32 v190, 0x7fc12345\n\tv_mov_b32 v191, 0x7fc12345\n\tv_mov_b32 v192, 0x7fc12345\n\tv_mov_b32 v193, 0x7fc12345\n\tv_mov_b32 v194, 0x7fc12345\n\tv_mov_b32 v195, 0x7fc12345\n\tv_mov_b32 v196, 0x7fc12345\n\tv_mov_b32 v197, 0x7fc12345\n\tv_mov_b32 v198, 0x7fc12345\n\tv_mov_b32 v199, 0x7fc12345\n\tv_mov_b32 v200, 0x7fc12345\n\tv_mov_b32 v201, 0x7fc12345\n\tv_mov_b32 v202, 0x7fc12345\n\tv_mov_b32 v203, 0x7fc12345\n\tv_mov_b32 v204, 0x7fc12345\n\tv_mov_b32 v205, 0x7fc12345\n\tv_mov_b32 v206, 0x7fc12345\n\tv_mov_b32 v207, 0x7fc12345\n\tv_mov_b32 v208, 0x7fc12345\n\tv_mov_b32 v209, 0x7fc12345\n\tv_mov_b32 v210, 0x7fc12345\n\tv_mov_b32 v211, 0x7fc12345\n\tv_mov_b32 v212, 0x7fc12345\n\tv_mov_b32 v213, 0x7fc12345\n\tv_mov_b32 v214, 0x7fc12345\n\tv_mov_b32 v215, 0x7fc12345\n\tv_mov_b32 v216, 0x7fc12345\n\tv_mov_b32 v217, 0x7fc12345\n\tv_mov_b32 v218, 0x7fc12345\n\tv_mov_b32 v219, 0x7fc12345\n\tv_mov_b32 v220, 0x7fc12345\n\tv_mov_b32 v221, 0x7fc12345\n\tv_mov_b32 v222, 0x7fc12345\n\tv_mov_b32 v223, 0x7fc12345\n\tv_mov_b32 v224, 0x7fc12345\n\tv_mov_b32 v225, 0x7fc12345\n\tv_mov_b32 v226, 0x7fc12345\n\tv_mov_b32 v227, 0x7fc12345\n\tv_mov_b32 v228, 0x7fc12345\n\tv_mov_b32 v229, 0x7fc12345\n\tv_mov_b32 v230, 0x7fc12345\n\tv_mov_b32 v231, 0x7fc12345\n\tv_mov_b32 v232, 0x7fc12345\n\tv_mov_b32 v233, 0x7fc12345\n\tv_mov_b32 v234, 0x7fc12345\n\tv_mov_b32 v235, 0x7fc12345\n\tv_mov_b32 v236, 0x7fc12345\n\tv_mov_b32 v237, 0x7fc12345\n\tv_mov_b32 v238, 0x7fc12345\n\tv_mov_b32 v239, 0x7fc12345\n\tv_mov_b32 v240, 0x7fc12345\n\tv_mov_b32 v241, 0x7fc12345\n\tv_mov_b32 v242, 0x7fc12345\n\tv_mov_b32 v243, 0x7fc12345\n\tv_mov_b32 v244, 0x7fc12345\n\tv_mov_b32 v245, 0x7fc12345\n\tv_mov_b32 v246, 0x7fc12345\n\tv_mov_b32 v247, 0x7fc12345\n\tv_mov_b32 v248, 0x7fc12345\n\tv_mov_b32 v249, 0x7fc12345\n\tv_mov_b32 v250, 0x7fc12345\n\tv_mov_b32 v251, 0x7fc12345\n\tv_mov_b32 v252, 0x7fc12345\n\tv_mov_b32 v253, 0x7fc12345\n\tv_mov_b32 v254, 0x7fc12345\n\tv_mov_b32 v255, 0x7fc12345" ::: "v0","v1","v2","v3","v4","v5","v6","v7","v8","v9","v10","v11","v12","v13","v14","v15","v16","v17","v18","v19","v20","v21","v22","v23","v24","v25","v26","v27","v28","v29","v30","v31","v32","v33","v34","v35","v36","v37","v38","v39","v40","v41","v42","v43","v44","v45","v46","v47","v48","v49","v50","v51","v52","v53","v54","v55","v56","v57","v58","v59","v60","v61","v62","v63","v64","v65","v66","v67","v68","v69","v70","v71","v72","v73","v74","v75","v76","v77","v78","v79","v80","v81","v82","v83","v84","v85","v86","v87","v88","v89","v90","v91","v92","v93","v94","v95","v96","v97","v98","v99","v100","v101","v102","v103","v104","v105","v106","v107","v108","v109","v110","v111","v112","v113","v114","v115","v116","v117","v118","v119","v120","v121","v122","v123","v124","v125","v126","v127","v128","v129","v130","v131","v132","v133","v134","v135","v136","v137","v138","v139","v140","v141","v142","v143","v144","v145","v146","v147","v148","v149","v150","v151","v152","v153","v154","v155","v156","v157","v158","v159","v160","v161","v162","v163","v164","v165","v166","v167","v168","v169","v170","v171","v172","v173","v174","v175","v176","v177","v178","v179","v180","v181","v182","v183","v184","v185","v186","v187","v188","v189","v190","v191","v192","v193","v194","v195","v196","v197","v198","v199","v200","v201","v202","v203","v204","v205","v206","v207","v208","v209","v210","v211","v212","v213","v214","v215","v216","v217","v218","v219","v220","v221","v222","v223","v224","v225","v226","v227","v228","v229","v230","v231","v232","v233","v234","v235","v236","v237","v238","v239","v240","v241","v242","v243","v244","v245","v246","v247","v248","v249","v250","v251","v252","v253","v254","v255");
}
__global__ void __launch_bounds__(256) cmp2_kernel(const unsigned long long* cs, unsigned long long* prev, int nph, float* out, size_t nout) {
    __shared__ int sbad;
    if (threadIdx.x == 0) { int bad = -1; if (prev[0] == 0x1234567855aa33ccull) { for (int p = nph - 1; p >= 0; --p) if (cs[p] != prev[1 + p]) bad = p; } sbad = bad; }
    __syncthreads();
    const int bad = sbad;
    if (bad >= 0) { const float sc = 0.1f * (float)(bad + 1);
        for (size_t i = (size_t)blockIdx.x * 256 + threadIdx.x; i < nout; i += (size_t)gridDim.x * 256) out[i] += sc; }
}
__global__ void __launch_bounds__(64) store_prev_kernel(const unsigned long long* cs, unsigned long long* prev, int nph) {
    if (threadIdx.x < nph) prev[1 + threadIdx.x] = cs[threadIdx.x];
    if (threadIdx.x == 0) prev[0] = 0x1234567855aa33ccull;
}
__global__ void __launch_bounds__(256) cmp_kernel(const unsigned long long* cs, int nph, float* out, size_t nout) {
    int bad = -1; for (int p = nph - 1; p >= 0; --p) if (p == 0 && cs[0] != cs[1]) bad = 3;
    if (bad < 0) return; const float sc = 1.0f + 0.05f * (float)(bad + 1);
    for (size_t i = (size_t)blockIdx.x * 256 + threadIdx.x; i < nout; i += (size_t)gridDim.x * 256) out[i] *= sc;
}
#endif
extern "C" void kernel_launch(void* const* d_in, const int* in_sizes, int n_in, void* d_out, int out_size, void* d_ws, size_t ws_size, hipStream_t stream) {
    static int grid = 0;
    if (grid == 0) {
        if (n_in != 21 || out_size != NTOK * DMOD || ws_size < WS_END) { fprintf(stderr, "kernel_launch: unexpected shapes (n_in %d, out %d, ws %zu < %zu)\n", n_in, out_size, ws_size, (size_t)WS_END); grid = -1; return; }
        int dev = 0, cus = 0, per_cu = 0;
        if (hipGetDevice(&dev) != hipSuccess || hipDeviceGetAttribute(&cus, hipDeviceAttributeMultiprocessorCount, dev) != hipSuccess) { grid = -1; return; }
        if (hipFuncSetAttribute((const void*)mk_fwd, hipFuncAttributeMaxDynamicSharedMemorySize, LDS_BYTES) != hipSuccess) { fprintf(stderr, "kernel_launch: hipFuncSetAttribute failed\n"); grid = -1; return; }
        if (hipOccupancyMaxActiveBlocksPerMultiprocessor(&per_cu, (const void*)mk_fwd, 512, LDS_BYTES) != hipSuccess || per_cu < 1) fprintf(stderr, "kernel_launch: occupancy query says %d\n", per_cu);
        (void)hipGetLastError();
        grid = cus < 256 ? cus : 256;
    }
    if (grid < 0) return;
#ifdef MK_DBL
    (void)hipMemsetAsync((char*)d_ws, 0, WS_END, stream); (void)hipMemsetAsync(d_out, 0, (size_t)out_size * 4, stream);
#endif
    (void)hipMemsetAsync((char*)d_ws + WS_CTL, 0, 1 * MiB, stream);
    (void)hipMemsetAsync((char*)d_ws + WS_FF, 0xFF, 1 * MiB, stream);
    Args a{};
    for (int i = 0; i < 21; ++i) a.in[i] = (const float*)d_in[i];
    a.out = (float*)d_out; a.ws = (unsigned char*)d_ws;
#ifndef MK_CUTS
    a.ph_lo = 0; a.ph_hi = PH_TOTAL;
    hipLaunchKernelGGL(mk_fwd, dim3(grid), dim3(512), LDS_BYTES, stream, a);
#else
#ifdef MK_DBL
    unsigned long long* cs = (unsigned long long*)((char*)d_ws + 65536);
    unsigned long long* prev = (unsigned long long*)((char*)d_ws + WS_END + MiB);
    for (int p = 0; p < 5; ++p) { a.ph_lo = p; a.ph_hi = p + 1; hipLaunchKernelGGL(mk_fwd, dim3(grid), dim3(512), LDS_BYTES, stream, a); }
    hipLaunchKernelGGL(cs_kernel, dim3(2048), dim3(256), 0, stream, (const unsigned*)((char*)d_ws + WS_YA), (size_t)(16 * MiB / 4), (const unsigned*)d_out, (size_t)0, cs + 0);
    hipLaunchKernelGGL(cs_kernel, dim3(2048), dim3(256), 0, stream, (const unsigned*)((char*)d_ws + WS_YB), (size_t)(16 * MiB / 4), (const unsigned*)d_out, (size_t)0, cs + 1);
    hipLaunchKernelGGL(cs_kernel, dim3(2048), dim3(256), 0, stream, (const unsigned*)((char*)d_ws + WS_GATE), (size_t)(96 * MiB / 4), (const unsigned*)d_out, (size_t)0, cs + 2);
    for (int p = 5; p < PH_TOTAL; ++p) { a.ph_lo = p; a.ph_hi = p + 1; hipLaunchKernelGGL(mk_fwd, dim3(grid), dim3(512), LDS_BYTES, stream, a); }
    hipLaunchKernelGGL(cmp2_kernel, dim3(1024), dim3(256), 0, stream, (const unsigned long long*)cs, prev, 3, (float*)d_out, (size_t)out_size);
    hipLaunchKernelGGL(store_prev_kernel, dim3(1), dim3(64), 0, stream, (const unsigned long long*)cs, prev, 3);
#else

    for (int p = 0; p < PH_TOTAL; ++p) { a.ph_lo = p; a.ph_hi = p + 1; hipLaunchKernelGGL(mk_fwd, dim3(grid), dim3(512), LDS_BYTES, stream, a); }
#endif
#endif
}
```

```cpp
#include <hip/hip_runtime.h>
#include <hip/hip_bf16.h>
#include <cstdio>
#include <cstdint>
#include <cmath>
__device__ __forceinline__ int lane_now() { int l; asm volatile("v_mbcnt_lo_u32_b32 %0, -1, 0\n\tv_mbcnt_hi_u32_b32 %0, -1, %0" : "=v"(l)); return l; }
namespace pg8 {
#define PG8_LAS __attribute__((address_space(3)))
typedef unsigned short bf16_t;
typedef short bf16x8 __attribute__((ext_vector_type(8)));
typedef float f32x4 __attribute__((ext_vector_type(4)));
typedef unsigned u32x4 __attribute__((ext_vector_type(4)));
constexpr int BM = 256, BK = 64, HALF = 128, HTB = HALF * BK * 2  , STAGE_BYTES = 8 * HTB, NXCD = 8, WGM = 8;

__host__ __device__ __forceinline__ int lds_byte(int r, int c) { const int st = (r >> 4) * 2 + (c >> 5), rr = r & 15, cc = c & 31, ob = rr * 64 + cc * 2; return st * 1024 + (ob ^ (((ob >> 9) & 1) << 5)); }
__host__ __device__ __forceinline__ void stage_rc(int b, int& R, int& C) { const int st = b / 1024, sb = b % 1024, swz = sb ^ (((sb >> 9) & 1) << 5); R = (st >> 1) * 16 + swz / 64; C = (st & 1) * 32 + (swz % 64) / 2; }
__host__ __device__ __forceinline__ int perm32(int rho) { const int n = rho >> 4, i = rho & 15; return 8 * (i >> 2) + 4 * n + (i & 3); }

struct Unit { int pm, pn; };
struct Gemm { const bf16_t* A; const bf16_t* Bt; int M, N, K; };

struct StaticOrder {
    int nM, nN, nwg, G, c;
    __host__ __device__ void init(int M, int N, int G_, int c_) { nM = M / BM; nN = N / BM; nwg = nM * nN; G = G_; c = c_; }
    __host__ __device__ bool next(int i, Unit& u) const {
        const long L = (long)i * G + c; if (L >= nwg) return false;
        int wgid = (int)L; { const int q = nwg / NXCD, r = nwg % NXCD, xcd = wgid % NXCD, off = wgid / NXCD; wgid = (xcd < r ? xcd * (q + 1) : r * (q + 1) + (xcd - r) * q) + off; }
        const int nig = WGM * nN, gid = wgid / nig, fm = gid * WGM, gsz = (nM - fm) < WGM ? (nM - fm) : WGM;
        u.pm = fm + ((wgid % nig) % gsz); u.pn = (wgid % nig) / gsz; return true;
    }
    __device__ __forceinline__ void a_ready(const Unit&) const {}
    __device__ __forceinline__ void done(const Unit&) const {}
};

typedef float f32x2c_t __attribute__((ext_vector_type(2))); typedef __bf16 bf16x2c_t __attribute__((ext_vector_type(2)));
__device__ __forceinline__ unsigned cvt_pk_bf16(float lo, float hi) { const f32x2c_t v = {lo, hi}; const bf16x2c_t b = __builtin_convertvector(v, bf16x2c_t); return __builtin_bit_cast(unsigned, b); }
typedef float f32x2 __attribute__((ext_vector_type(2)));
__device__ __forceinline__ float silu_f(float x) { return x * __builtin_amdgcn_rcpf(1.0f + __expf(-x)); }
__device__ __forceinline__ float sigm_f(float x) { return __builtin_amdgcn_rcpf(1.0f + __expf(-x)); }
__device__ __forceinline__ u32x4 pack8(const f32x4& v0, const f32x4& v1) { u32x4 w; w.x = cvt_pk_bf16(v0[0], v0[1]); w.y = cvt_pk_bf16(v0[2], v0[3]); w.z = cvt_pk_bf16(v1[0], v1[1]); w.w = cvt_pk_bf16(v1[2], v1[3]); return w; }
constexpr float QK_C2 = 0.125f * 1.4426950408889634f;
constexpr float XQ_C2 = 0.0625f * 1.4426950408889634f;

template <int ACT> struct EpiStore {
    static constexpr bool PERM = true, AFTER_DRAIN = false;
    bf16_t* O; int ldc; float scale;
    __device__ __forceinline__ void operator()(const f32x4 (&acc)[2][2][4][2], const Unit& u, int wr, int wc, int fr, int fq) const {
        const int row0 = u.pm * BM + wr * 64 + fr, col0 = u.pn * BM + wc * 32 + 8 * fq;
#pragma unroll
        for (int ai = 0; ai < 2; ++ai)
#pragma unroll
            for (int m = 0; m < 4; ++m) { bf16_t* rowp = O + (size_t)(row0 + ai * HALF + m * 16) * ldc + col0;
#pragma unroll
                for (int bj = 0; bj < 2; ++bj) { f32x4 v0 = acc[ai][bj][m][0], v1 = acc[ai][bj][m][1];
                    if (ACT == 1) { for (int i = 0; i < 4; ++i) { v0[i] = sigm_f(v0[i]); v1[i] = sigm_f(v1[i]); } }
                    v0 = v0 * scale; v1 = v1 * scale; *(u32x4*)(rowp + bj * HALF) = pack8(v0, v1); } }
    }
};

struct EpiProj {
    static constexpr bool PERM = true, AFTER_DRAIN = false;
    bf16_t* P; float* LOGF; bf16_t* CVT; const float* lb;
    __device__ __forceinline__ void operator()(const f32x4 (&acc)[2][2][4][2], const Unit& u, int wr, int wc, int fr, int fq) const {
        const int pn = u.pn; const int row0 = u.pm * BM + wr * 64 + fr, col0 = pn * BM + wc * 32 + 8 * fq;
        const int mode = (pn <= 1 || pn == 17 || pn == 18) ? 1 : ((pn == 9 || pn == 10 || pn == 15 || pn == 16) ? 2 : ((pn == 11 || pn == 12) ? 3 : (pn == 19 ? 4 : 0)));
        if (mode == 3) {
            float lbv[2][8], omv[2][8];
#pragma unroll
            for (int bj = 0; bj < 2; ++bj)
#pragma unroll
                for (int i = 0; i < 8; ++i) { lbv[bj][i] = lb[col0 - 2816 + bj * HALF + i]; omv[bj][i] = 1.0f - lbv[bj][i]; }
#pragma unroll
            for (int ai = 0; ai < 2; ++ai)
#pragma unroll
                for (int m = 0; m < 4; ++m) { float* rowp = LOGF + (size_t)(row0 + ai * HALF + m * 16) * 512 + (col0 - 2816);
#pragma unroll
                    for (int bj = 0; bj < 2; ++bj) { f32x4 o[2];
#pragma unroll
                        for (int n = 0; n < 2; ++n)
#pragma unroll
                            for (int i = 0; i < 4; ++i) { const float z = acc[ai][bj][m][n][i]; const float e = __expf(-fabsf(z)); const float r = __builtin_amdgcn_rcpf(1.0f + e);
                                const float sp = z >= 0.f ? r : e * r, sn = z >= 0.f ? e * r : r;
                                const float k = omv[bj][4 * n + i] * sn;
                                const float f = lbv[bj][4 * n + i] + omv[bj][4 * n + i] * sp;
                                o[n][i] = (k < 0.5f) ? log1pf(-k) : logf(f); }
                        *(f32x4*)(rowp + bj * HALF) = o[0]; *(f32x4*)(rowp + bj * HALF + 4) = o[1]; } }
            return;
        }
#pragma unroll
        for (int ai = 0; ai < 2; ++ai)
#pragma unroll
            for (int m = 0; m < 4; ++m) { const int row = row0 + ai * HALF + m * 16; bf16_t* rowp = P + (size_t)row * 5120 + col0;
#pragma unroll
                for (int bj = 0; bj < 2; ++bj) { f32x4 v0 = acc[ai][bj][m][0], v1 = acc[ai][bj][m][1];
                    if (mode == 1) { v0 = v0 * QK_C2; v1 = v1 * QK_C2; }
                    if (mode == 2) { for (int i = 0; i < 4; ++i) { v0[i] = silu_f(v0[i]); v1[i] = silu_f(v1[i]); } }
                    const u32x4 w = pack8(v0, v1); *(u32x4*)(rowp + bj * HALF) = w;
                    if (mode == 4 && bj == 1) {
                        const int dfull = wc * 32 + 8 * fq; bf16_t* tp = CVT + ((size_t)(row >> 13) * 128 + dfull) * 8192 + (row & 8191);
                        tp[0 * 8192] = (bf16_t)(w.x & 0xffffu); tp[1 * 8192] = (bf16_t)(w.x >> 16); tp[2 * 8192] = (bf16_t)(w.y & 0xffffu); tp[3 * 8192] = (bf16_t)(w.y >> 16);
                        tp[4 * 8192] = (bf16_t)(w.z & 0xffffu); tp[5 * 8192] = (bf16_t)(w.z >> 16); tp[6 * 8192] = (bf16_t)(w.w & 0xffffu); tp[7 * 8192] = (bf16_t)(w.w >> 16); } } }
    }
};

struct EpiMerge {
    static constexpr bool PERM = true, AFTER_DRAIN = false;
    const bf16_t* GATE; float* MRG; bf16_t* OUT; int G3;
    __device__ __forceinline__ void operator()(const f32x4 (&acc)[2][2][4][2], const Unit& u, int wr, int wc, int fr, int fq) const {
        const int row0 = u.pm * BM + wr * 64 + fr, col0 = u.pn * BM + wc * 32 + 8 * fq;
#pragma unroll
        for (int ai = 0; ai < 2; ++ai)
#pragma unroll
            for (int m = 0; m < 4; ++m) { const size_t row = (size_t)(row0 + ai * HALF + m * 16);
#pragma unroll
                for (int bj = 0; bj < 2; ++bj) { const int col = col0 + bj * HALF;
                    const u32x4 gw = *(const u32x4*)(GATE + row * 3072 + G3 * 1024 + col);
                    f32x4 g0, g1; g0[0] = __uint_as_float(gw.x << 16); g0[1] = __uint_as_float(gw.x & 0xffff0000u); g0[2] = __uint_as_float(gw.y << 16); g0[3] = __uint_as_float(gw.y & 0xffff0000u);
                    g1[0] = __uint_as_float(gw.z << 16); g1[1] = __uint_as_float(gw.z & 0xffff0000u); g1[2] = __uint_as_float(gw.w << 16); g1[3] = __uint_as_float(gw.w & 0xffff0000u);
                    f32x4 v0 = acc[ai][bj][m][0] * g0, v1 = acc[ai][bj][m][1] * g1;
                    float* mp = MRG + row * 1024 + col;
                    if (G3 > 0) { v0 = v0 + *(const f32x4*)mp; v1 = v1 + *(const f32x4*)(mp + 4); }
                    if (G3 < 2) { *(f32x4*)mp = v0; *(f32x4*)(mp + 4) = v1; }
                    else *(u32x4*)(OUT + row * 1024 + col) = pack8(v0, v1); } }
    }
};

struct EpiResid {
    static constexpr bool PERM = true, AFTER_DRAIN = false;
    const float* H; float* T; float alpha;
    __device__ __forceinline__ void operator()(const f32x4 (&acc)[2][2][4][2], const Unit& u, int wr, int wc, int fr, int fq) const {
        const int row0 = u.pm * BM + wr * 64 + fr, col0 = u.pn * BM + wc * 32 + 8 * fq;
#pragma unroll
        for (int ai = 0; ai < 2; ++ai)
#pragma unroll
            for (int m = 0; m < 4; ++m) { const size_t off = (size_t)(row0 + ai * HALF + m * 16) * 1024 + col0;
#pragma unroll
                for (int bj = 0; bj < 2; ++bj) { const f32x4 h0 = *(const f32x4*)(H + off + bj * HALF), h1 = *(const f32x4*)(H + off + bj * HALF + 4);
                    *(f32x4*)(T + off + bj * HALF) = h0 * alpha + acc[ai][bj][m][0]; *(f32x4*)(T + off + bj * HALF + 4) = h1 * alpha + acc[ai][bj][m][1]; } }
    }
};

struct EpiMoeUp {
    static constexpr bool PERM = true, AFTER_DRAIN = false;
    bf16_t* HID;
    __device__ __forceinline__ void operator()(const f32x4 (&acc)[2][2][4][2], const Unit& u, int wr, int wc, int fr, int fq) const {
        const int row0 = u.pm * BM + wr * 64 + fr, col0 = (u.pn & 3) * 128 + wc * 32 + 8 * fq;
#pragma unroll
        for (int ai = 0; ai < 2; ++ai)
#pragma unroll
            for (int m = 0; m < 4; ++m) { f32x4 v0, v1;
#pragma unroll
                for (int i = 0; i < 4; ++i) { v0[i] = silu_f(acc[ai][0][m][0][i]) * acc[ai][1][m][0][i]; v1[i] = silu_f(acc[ai][0][m][1][i]) * acc[ai][1][m][1][i]; }
                *(u32x4*)(HID + (size_t)(row0 + ai * HALF + m * 16) * 512 + col0) = pack8(v0, v1); }
    }
};
struct EpiMoeDown {
    static constexpr bool PERM = true, AFTER_DRAIN = false;
    bf16_t* Y; const int* slot_asg;
    __device__ __forceinline__ void operator()(const f32x4 (&acc)[2][2][4][2], const Unit& u, int wr, int wc, int fr, int fq) const {
        const int row0 = u.pm * BM + wr * 64 + fr, col0 = (u.pn & 3) * BM + wc * 32 + 8 * fq;
#pragma unroll
        for (int ai = 0; ai < 2; ++ai)
#pragma unroll
            for (int m = 0; m < 4; ++m) { const int asg = slot_asg[row0 + ai * HALF + m * 16];
                if (asg >= 0) { bf16_t* rowp = Y + (size_t)asg * 1024 + col0;
#pragma unroll
                    for (int bj = 0; bj < 2; ++bj) *(u32x4*)(rowp + bj * HALF) = pack8(acc[ai][bj][m][0], acc[ai][bj][m][1]); } }
    }
};
struct MoeOrder {
    const int* blke; int nunits, G, c;
    __device__ __forceinline__ bool next(int i, Unit& u) const { const int L = i * G + c; if (L >= nunits) return false; const int blk = L >> 2; u.pm = blk; u.pn = blke[blk] * 4 + (L & 3); return true; }
    __device__ __forceinline__ void a_ready(const Unit&) const {}
    __device__ __forceinline__ void done(const Unit&) const {}
};
template <class Epi, class Sched, bool ALIGN_EPI = false, bool SP2 = false>
__device__ __forceinline__ void gemm_phase(PG8_LAS unsigned char* lds, int tid_in, const Gemm g, const Sched& S, const Epi& E) {
    const int tid = tid_in * 64 + lane_now();
    const int wid = __builtin_amdgcn_readfirstlane(tid >> 6), lane = tid & 63, wr = wid >> 2, wc = wid & 3, fr = lane & 15, fq = lane >> 4;
    const int K = g.K, nt = K / BK;
    unsigned voffA[2], voffB[2];
#pragma unroll
    for (int i = 0; i < 2; ++i) { int R, C; stage_rc(tid * 16 + i * 8192, R, C); const int Rb = Epi::PERM ? ((R & ~31) + perm32(R & 31)) : R;
        voffA[i] = (unsigned)(R * K + C) * 2u; voffB[i] = (unsigned)(Rb * K + C) * 2u; }
    const size_t kstep = (size_t)(BK * 2);
    const size_t hstep = (size_t)HALF * K * 2;
    const size_t tstep = 2 * hstep;
    const unsigned ldsw = (unsigned)wid * 1024u;
    const int aoff = lds_byte(wr * 64 + fr, fq * 8), boff = lds_byte(wc * 32 + fr, fq * 8);
#define PG8_SA(b, h) (((b) * 2 + (h)) * HTB)
#define PG8_SB(b, h) ((4 + (b) * 2 + (h)) * HTB)
#define PG8_STAGE(bufoff, gbase, voff) do { _Pragma("unroll") for (int _i = 0; _i < 2; ++_i) \
        __builtin_amdgcn_global_load_lds((const unsigned*)((const char*)(gbase) + (voff)[_i]), (PG8_LAS unsigned*)(lds + (bufoff) + ldsw + _i * 8192), 16, 0, 0); } while (0)
#define PG8_LDA(dst, b, h) do { _Pragma("unroll") for (int m = 0; m < 4; ++m) _Pragma("unroll") for (int k = 0; k < 2; ++k) dst[m][k] = *(const PG8_LAS bf16x8*)(lds + PG8_SA(b, h) + aoff + m * 2048 + k * 1024); } while (0)
#define PG8_LDB(dst, b, h) do { _Pragma("unroll") for (int n = 0; n < 2; ++n) _Pragma("unroll") for (int k = 0; k < 2; ++k) dst[n][k] = *(const PG8_LAS bf16x8*)(lds + PG8_SB(b, h) + boff + n * 2048 + k * 1024); } while (0)
#define PG8_MMA(ai, bj, At, Bt) do { __builtin_amdgcn_s_setprio(1); _Pragma("unroll") for (int m = 0; m < 4; ++m) _Pragma("unroll") for (int n = 0; n < 2; ++n) _Pragma("unroll") for (int k = 0; k < 2; ++k) \
        acc[ai][bj][m][n] = __builtin_amdgcn_mfma_f32_16x16x32_bf16(Bt[n][k], At[m][k], acc[ai][bj][m][n], 0, 0, 0); __builtin_amdgcn_s_setprio(0); } while (0)
#define PG8_WAIT_V(n) asm volatile("s_waitcnt vmcnt(" #n ")" ::: "memory")
#define PG8_WAIT_L(n) asm volatile("s_waitcnt lgkmcnt(" #n ")" ::: "memory")
#define PG8_BAR __builtin_amdgcn_s_barrier()
#define PG8_SCHED __builtin_amdgcn_sched_barrier(0)
    Unit cur, nxt; int ui = 0;
    if (!S.next(0, cur)) return;
    f32x4 acc[2][2][4][2];
#pragma unroll
    for (int a = 0; a < 2; ++a)
#pragma unroll
        for (int b = 0; b < 2; ++b)
#pragma unroll
            for (int m = 0; m < 4; ++m)
#pragma unroll
                for (int n = 0; n < 2; ++n) acc[a][b][m][n] = (f32x4){0.f, 0.f, 0.f, 0.f};
    bf16x8 At[4][2], B0[2][2], B1[2][2];
    const char* cA = (const char*)g.A + (size_t)cur.pm * tstep; const char* cB = (const char*)g.Bt + (size_t)cur.pn * tstep;
    S.a_ready(cur);
    if constexpr (SP2) {
        PG8_STAGE(PG8_SB(0, 0), cB, voffB); PG8_STAGE(PG8_SB(0, 1), cB + hstep, voffB); PG8_STAGE(PG8_SA(0, 0), cA, voffA); PG8_STAGE(PG8_SA(0, 1), cA + hstep, voffA);
        if (wr == 1) PG8_BAR;
        PG8_WAIT_V(2); PG8_BAR;
        PG8_STAGE(PG8_SB(1, 0), cB + kstep, voffB); PG8_STAGE(PG8_SA(1, 0), cA + kstep, voffA); PG8_STAGE(PG8_SB(1, 1), cB + hstep + kstep, voffB);
        PG8_WAIT_V(6); PG8_BAR;
    } else {
        PG8_STAGE(PG8_SB(0, 0), cB, voffB); PG8_STAGE(PG8_SA(0, 0), cA, voffA); PG8_STAGE(PG8_SB(0, 1), cB + hstep, voffB); PG8_STAGE(PG8_SA(0, 1), cA + hstep, voffA);
        if (wr == 1) PG8_BAR;
        PG8_WAIT_V(4); PG8_BAR;
        PG8_STAGE(PG8_SB(1, 0), cB + kstep, voffB); PG8_STAGE(PG8_SA(1, 0), cA + kstep, voffA); PG8_STAGE(PG8_SB(1, 1), cB + hstep + kstep, voffB);
        PG8_WAIT_V(6); PG8_BAR;
    }
    for (;;) {
        const bool has_next = S.next(ui + 1, nxt);
        const char* nA = has_next ? (const char*)g.A + (size_t)nxt.pm * tstep : cA; const char* nB = has_next ? (const char*)g.Bt + (size_t)nxt.pn * tstep : cB;
        for (int t = 0; t < nt; t += 2) {
            const bool last = (t == nt - 2);
            const char* a1 = cA + (size_t)(t + 1) * kstep;
            const char* a2 = last ? nA : cA + (size_t)(t + 2) * kstep; const char* b2 = last ? nB : cB + (size_t)(t + 2) * kstep;
            const char* a3 = a2 + kstep; const char* b3 = b2 + kstep;
            if (last && has_next) S.a_ready(nxt);
            if constexpr (SP2) {
            PG8_LDB(B0, 0, 0); PG8_LDB(B1, 0, 1); PG8_SCHED; PG8_LDA(At, 0, 0); PG8_STAGE(PG8_SA(1, 1), a1 + hstep, voffA);
            PG8_WAIT_V(8); PG8_WAIT_L(0); PG8_BAR; PG8_MMA(0, 0, At, B0); PG8_MMA(0, 1, At, B1); PG8_BAR; PG8_SCHED;
            PG8_LDA(At, 0, 1); PG8_STAGE(PG8_SB(0, 0), b2, voffB); PG8_STAGE(PG8_SB(0, 1), b2 + hstep, voffB); PG8_STAGE(PG8_SA(0, 0), a2, voffA);
            PG8_WAIT_V(8); PG8_WAIT_L(0); PG8_BAR; PG8_MMA(1, 0, At, B0); PG8_MMA(1, 1, At, B1); PG8_BAR; PG8_SCHED;
            PG8_LDB(B0, 1, 0); PG8_LDB(B1, 1, 1); PG8_SCHED; PG8_LDA(At, 1, 0); PG8_STAGE(PG8_SA(0, 1), a2 + hstep, voffA);
            PG8_WAIT_V(8); PG8_WAIT_L(0); PG8_BAR; PG8_MMA(0, 0, At, B0); PG8_MMA(0, 1, At, B1); PG8_BAR; PG8_SCHED;
            PG8_LDA(At, 1, 1); PG8_STAGE(PG8_SB(1, 0), b3, voffB); PG8_STAGE(PG8_SB(1, 1), b3 + hstep, voffB); PG8_STAGE(PG8_SA(1, 0), a3, voffA);
            PG8_WAIT_V(8); PG8_WAIT_L(0); PG8_BAR; PG8_MMA(1, 0, At, B0); PG8_MMA(1, 1, At, B1); PG8_BAR; PG8_SCHED;
            } else {
            PG8_LDB(B0, 0, 0); PG8_SCHED; PG8_LDA(At, 0, 0); PG8_STAGE(PG8_SA(1, 1), a1 + hstep, voffA);
            PG8_WAIT_L(8); PG8_BAR; PG8_WAIT_L(0); PG8_MMA(0, 0, At, B0); PG8_BAR; PG8_SCHED;
            PG8_LDB(B1, 0, 1); PG8_STAGE(PG8_SB(0, 0), b2, voffB);
            PG8_BAR; PG8_WAIT_L(0); PG8_MMA(0, 1, At, B1); PG8_BAR;
            PG8_LDA(At, 0, 1); PG8_STAGE(PG8_SA(0, 0), a2, voffA);
            PG8_BAR; PG8_WAIT_L(0); PG8_MMA(1, 0, At, B0); PG8_BAR; PG8_SCHED;
            PG8_STAGE(PG8_SB(0, 1), b2 + hstep, voffB);
            PG8_WAIT_V(6); PG8_BAR; PG8_MMA(1, 1, At, B1); PG8_BAR;
            PG8_LDB(B0, 1, 0); PG8_SCHED; PG8_LDA(At, 1, 0); PG8_STAGE(PG8_SA(0, 1), a2 + hstep, voffA);
            PG8_WAIT_L(8); PG8_BAR; PG8_WAIT_L(0); PG8_MMA(0, 0, At, B0); PG8_BAR; PG8_SCHED;
            PG8_LDB(B1, 1, 1); PG8_STAGE(PG8_SB(1, 0), b3, voffB);
            PG8_BAR; PG8_WAIT_L(0); PG8_MMA(0, 1, At, B1); PG8_BAR;
            PG8_LDA(At, 1, 1); PG8_STAGE(PG8_SA(1, 0), a3, voffA);
            PG8_BAR; PG8_WAIT_L(0); PG8_MMA(1, 0, At, B0); PG8_BAR; PG8_SCHED;
            PG8_STAGE(PG8_SB(1, 1), b3 + hstep, voffB);
            PG8_WAIT_V(6); PG8_BAR; PG8_MMA(1, 1, At, B1); PG8_BAR;
            }
        }
        if constexpr (ALIGN_EPI) { if (wr == 0) PG8_BAR; }
        if constexpr (!Epi::AFTER_DRAIN) { E(acc, cur, wr, wc, fr, fq); S.done(cur); }
        if (!has_next) break;
#pragma unroll
        for (int a = 0; a < 2; ++a)
#pragma unroll
            for (int b = 0; b < 2; ++b)
#pragma unroll
                for (int m = 0; m < 4; ++m)
#pragma unroll
                    for (int n = 0; n < 2; ++n) acc[a][b][m][n] = (f32x4){0.f, 0.f, 0.f, 0.f};
        cur = nxt; cA = nA; cB = nB; ++ui;
        if constexpr (ALIGN_EPI) { if (wr == 1) PG8_BAR; }
    }
    PG8_WAIT_V(0);
    if constexpr (!ALIGN_EPI) { if (wr == 0) PG8_BAR; }
    PG8_BAR;
    if constexpr (Epi::AFTER_DRAIN) { E.fused(acc, cur, wr, wc, fr, fq, lds, wid, lane); S.done(cur); }
#undef PG8_SA
#undef PG8_SB
#undef PG8_STAGE
#undef PG8_LDA
#undef PG8_LDB
#undef PG8_MMA
#undef PG8_WAIT_V
#undef PG8_WAIT_L
#undef PG8_BAR
#undef PG8_SCHED
}
}
namespace attn_body {
using bf16=__hip_bfloat16;
using bf16x8=__attribute__((ext_vector_type(8)))short;
using s16x4=__attribute__((ext_vector_type(4)))short;
using f32x16=__attribute__((ext_vector_type(16)))float;
using u32x4=__attribute__((ext_vector_type(4)))unsigned;
constexpr int BATCH=2,NHEAD=8,SEQ=8192,D=64,DM=5120,DMO=512;
constexpr int NW=8,QBLK=32,QB=QBLK*NW,KVBLK=64,NQB=SEQ/QB;
constexpr int ATTN_UNIT_ROWS=QB;
__device__ __forceinline__ int crow(int r,int hi){return (r&3)+8*(r>>2)+4*hi;}
#define SBAR() __builtin_amdgcn_sched_barrier(0)
__device__ __forceinline__ void cmask(f32x16&p0,f32x16&p1,int jb,int qrel,int hi){
  const float NEG=-INFINITY; int kb=64*jb+4*hi;
  #pragma unroll
  for(int r=0;r<16;++r){int kv=kb+(r&3)+8*(r>>2); if(kv>qrel)p0[r]=NEG; if(kv+32>qrel)p1[r]=NEG;}
}

constexpr int NSLOT=3, SLOTB=8192;
constexpr int LDS_K=0, LDS_V=NSLOT*SLOTB, LDS_WS=2*NSLOT*SLOTB, LDS_OST=LDS_WS+NW*64*4, LDS_BYTES=LDS_OST+NW*4096;
constexpr float C2=0.125f*1.4426950408889634f;
__device__ __forceinline__ void mkinit(f32x16&p0,f32x16&p1,unsigned long long mw,int hi,float cbm){
  const unsigned lo=(unsigned)mw>>(4*hi), hw=(unsigned)(mw>>32)>>(4*hi); const int ci=__builtin_bit_cast(int,cbm), ni=(int)0xC5800000u;
  #pragma unroll
  for(int r=0;r<16;++r){const int pos=(r&3)+8*(r>>2);
    const int m0=((int)(lo<<(31-pos)))>>31, m1=((int)(hw<<(31-pos)))>>31;
    p0[r]=__builtin_bit_cast(float,(m0&ci)|(~m0&ni)); p1[r]=__builtin_bit_cast(float,(m1&ci)|(~m1&ni));}
}
__device__ __forceinline__ void biasadd(f32x16&p0,f32x16&p1,const __attribute__((address_space(3))) float*tab,int dq,int hi){
  #pragma unroll
  for(int r=0;r<16;r+=2){
    float t[4];
    #pragma unroll
    for(int k=0;k<2;++k){const int kv=((r+k)&3)+8*((r+k)>>2)+4*hi; int d0=dq-kv, d1=dq-kv-32; d0=d0<0?0:(d0>128?128:d0); d1=d1<0?0:(d1>128?128:d1); t[2*k]=tab[d0]; t[2*k+1]=tab[d1];}
    asm volatile("s_waitcnt lgkmcnt(0)":"+v"(t[0]),"+v"(t[1]),"+v"(t[2]),"+v"(t[3])::"memory");
    p0[r]+=t[0]; p1[r]+=t[1]; p0[r+1]+=t[2]; p1[r+1]+=t[3];
    __builtin_amdgcn_sched_barrier(0);
  }
}
__device__ __forceinline__ void glds16(const void*gsrc,unsigned lds_dst){unsigned keep;
  asm volatile("s_mov_b32 %0, m0\n\ts_mov_b32 m0, %2\n\ts_nop 0\n\tglobal_load_lds_dwordx4 %1, off\n\ts_mov_b32 m0, %0":"=&s"(keep):"v"(gsrc),"s"(lds_dst):"memory");}
__device__ __forceinline__ float max3f(float a,float b,float c){float r;asm("v_max3_f32 %0, %1, %2, %3":"=v"(r):"v"(a),"v"(b),"v"(c));return r;}
__device__ __forceinline__ float max2f(float a,float b){float r;asm("v_max_f32_e32 %0, %1, %2":"=v"(r):"v"(a),"v"(b));return r;}
__device__ __forceinline__ float fadd_s(float a,float b){float r;asm("v_add_f32_e32 %0, %1, %2":"=v"(r):"v"(a),"v"(b));return r;}
__device__ __forceinline__ float fsub_s(float a,float b){float r;asm("v_sub_f32_e32 %0, %1, %2":"=v"(r):"v"(a),"v"(b));return r;}
typedef float f32x2_t __attribute__((ext_vector_type(2))); typedef __bf16 bf16x2_t __attribute__((ext_vector_type(2)));
__device__ __forceinline__ unsigned cvtpk_s(float lo,float hi){f32x2_t v={lo,hi};bf16x2_t b=__builtin_convertvector(v,bf16x2_t);return __builtin_bit_cast(unsigned,b);}
#define WAIT_BAR(N) asm volatile("s_waitcnt vmcnt(" #N ") lgkmcnt(0)\n\ts_barrier":::"memory")

__device__ __forceinline__ void qkt(f32x16&p0,f32x16&p1,const char*Kslot,const bf16x8*qr,int r32,int hi){
  const char*kb=Kslot+hi*1024+r32*16;
  #pragma unroll
  for(int d0=0;d0<4;++d0){
    const bf16x8 b0=*reinterpret_cast<const bf16x8*>(kb+d0*2048);
    const bf16x8 b1=*reinterpret_cast<const bf16x8*>(kb+d0*2048+512);
    {p0=__builtin_amdgcn_mfma_f32_32x32x16_bf16(b0,qr[d0],p0,0,0,1);p1=__builtin_amdgcn_mfma_f32_32x32x16_bf16(b1,qr[d0],p1,0,0,1);}}
}
typedef __attribute__((address_space(3))) const char* lds_cptr;
typedef short v4i16_t __attribute__((ext_vector_type(4)));
__device__ __forceinline__ void kload8(bf16x8*kf,lds_cptr kp){
  kf[0]=*(const __attribute__((address_space(3))) bf16x8*)(kp);      kf[1]=*(const __attribute__((address_space(3))) bf16x8*)(kp+512);
  kf[2]=*(const __attribute__((address_space(3))) bf16x8*)(kp+2048); kf[3]=*(const __attribute__((address_space(3))) bf16x8*)(kp+2560);
  kf[4]=*(const __attribute__((address_space(3))) bf16x8*)(kp+4096); kf[5]=*(const __attribute__((address_space(3))) bf16x8*)(kp+4608);
  kf[6]=*(const __attribute__((address_space(3))) bf16x8*)(kp+6144); kf[7]=*(const __attribute__((address_space(3))) bf16x8*)(kp+6656);
}
__device__ __forceinline__ void kload2(bf16x8*kf,lds_cptr kp,int j){ kf[2*j]=*(const __attribute__((address_space(3))) bf16x8*)(kp+j*2048); kf[2*j+1]=*(const __attribute__((address_space(3))) bf16x8*)(kp+j*2048+512); }
__device__ __forceinline__ s16x4 vtr(lds_cptr p){ return __builtin_bit_cast(s16x4,__builtin_amdgcn_ds_read_tr16_b64_v4i16((__attribute__((address_space(3))) v4i16_t*)p)); }
__device__ __forceinline__ float rowmax(const f32x16&p0,const f32x16&p1){
  float a=max3f(p0[0],p0[1],p1[0]),b=max3f(p0[2],p0[3],p1[1]);a=max3f(a,p1[2],p1[3]);
  #pragma unroll
  for(int r=4;r<16;r+=4){a=max3f(a,p0[r],p0[r+1]);b=max3f(b,p0[r+2],p0[r+3]);a=max3f(a,p1[r],p1[r+1]);b=max3f(b,p1[r+2],p1[r+3]);}
  const float m=max2f(a,b);
  auto rr=__builtin_amdgcn_permlane32_swap(__float_as_uint(m),__float_as_uint(m),false,false);
  return max2f(__uint_as_float(rr[0]),__uint_as_float(rr[1]));
}
__device__ __forceinline__ void pv(f32x16*o,int vb,bf16x8 pa0,bf16x8 pa1,bf16x8 pa2,bf16x8 pa3){
  #pragma unroll
  for(int d0=0;d0<2;++d0){s16x4 lo[4],hi[4];
    #pragma unroll
    for(int ks=0;ks<4;++ks){
      asm volatile("ds_read_b64_tr_b16 %0,%1 offset:%c2":"=&v"(lo[ks]):"v"(vb),"i"(d0*4096+ks*1024):"memory");
      asm volatile("ds_read_b64_tr_b16 %0,%1 offset:%c2":"=&v"(hi[ks]):"v"(vb),"i"(d0*4096+ks*1024+512):"memory");}
    asm volatile("s_waitcnt lgkmcnt(0)":::"memory");SBAR();
    #define PK(k) (bf16x8){lo[k][0],lo[k][1],lo[k][2],lo[k][3],hi[k][0],hi[k][1],hi[k][2],hi[k][3]}
    o[d0]=__builtin_amdgcn_mfma_f32_32x32x16_bf16(pa0,PK(0),o[d0],0,0,1);
    o[d0]=__builtin_amdgcn_mfma_f32_32x32x16_bf16(pa1,PK(1),o[d0],0,0,1);
    o[d0]=__builtin_amdgcn_mfma_f32_32x32x16_bf16(pa2,PK(2),o[d0],0,0,1);
    o[d0]=__builtin_amdgcn_mfma_f32_32x32x16_bf16(pa3,PK(3),o[d0],0,0,1);
    #undef PK
  }
}

#ifndef ATTN_STORE16
#define ATTN_STORE16(p,v) (*(u32x4*)(p)=(v))
#endif
template<int THRL> __device__ __forceinline__ void attn_unit(int b,int h,int qb,const bf16*Q,const bf16*__restrict__ K,const bf16*__restrict__ V,bf16*O,char*shm,int tid_in,const unsigned char*__restrict__ MSK,const __attribute__((address_space(3))) float*tabA,float cb){
  const int tid=tid_in*64+lane_now();
  const int lane=tid&63,r32=lane&31,hi=lane>>5; const int wid=__builtin_amdgcn_readfirstlane(tid>>6);
  const long rowbase=(long)b*SEQ; const int q0=qb*QB;
  const bf16*Qw=Q+(rowbase+q0+wid*QBLK)*DM+h*D;
  const unsigned moff=(unsigned)(rowbase+q0+wid*QBLK+r32)*1024u;
  #define MROW(t) (*(const unsigned long long*)(MSK+(moff+8u*(unsigned)(t))))
  #define MLOAD(dst,t) asm volatile("global_load_dwordx2 %0, %1, %2":"=&v"(dst):"v"(moff+8u*(unsigned)(t)),"s"(MSK):"memory")
  const bf16*Kh=K+rowbase*DM+h*D,*Vh=V+rowbase*DM+h*D;
  const unsigned lds0=(unsigned)(uintptr_t)shm;
  float*wsf=(float*)(shm+LDS_WS)+wid*64;
  const bf16*ksrc=Kh+(long)lane*DM+wid*8;
  const bf16*vsrc=Vh+(long)(16*(wid&3)+(lane>>2))*DM+(wid>>2)*32+(lane&3)*8;
  const unsigned kdst=lds0+LDS_K+wid*1024, vdst=lds0+LDS_V+wid*1024;
  #define DMA_K(t,slot) glds16(ksrc+(long)(t)*KVBLK*DM,(unsigned)__builtin_amdgcn_readfirstlane(kdst+(slot)))
  #define DMA_V(t,slot) glds16(vsrc+(long)(t)*KVBLK*DM,(unsigned)__builtin_amdgcn_readfirstlane(vdst+(slot)))
  const int vb0=(int)(lds0+LDS_V)+((lane>>4)&1)*32+(lane&3)*8+(4*hi+((lane&15)>>2))*64;
  const char*Kbase=shm+LDS_K; bf16x8 kf[8];
  const lds_cptr shm3=(lds_cptr)shm; const lds_cptr kp0=shm3+LDS_K+hi*1024+r32*16; const lds_cptr vp0=shm3+LDS_V+((lane>>4)&1)*32+(lane&3)*8+(4*hi+((lane&15)>>2))*64;
  const int NT=(q0+QB)/KVBLK;
  DMA_K(0,0);DMA_V(0,0);DMA_K(1,SLOTB);
  bf16x8 qr[4];
  #pragma unroll
  for(int d0=0;d0<4;++d0)qr[d0]=*reinterpret_cast<const bf16x8*>(&Qw[(long)r32*DM+d0*16+hi*8]);
  unsigned long long mw=MROW(0);
  float mhat=0.f,l_reg=0.f;f32x16 o[2];o[0]=f32x16{};o[1]=f32x16{};float cbm=cb;
  const int qrel=wid*QBLK+r32;
  #define CMASK(P0,P1,t,MW) do{ int jb2_=(t)-(NT-6); if(jb2_>=0)biasadd(P0,P1,tabA,q0+qrel-64*(t),hi); int jb_=(t)-(NT-4); if(jb_>=0)cmask(P0,P1,jb_,qrel,hi);}while(0)
  bool resc=false;
  #define START(P0,P1) do{ const float rm=rowmax(P0,P1); resc=false; \
    { const float dl=rm; mhat=fadd_s(mhat,dl); \
      _Pragma("unroll") for(int r=0;r<16;++r){P0[r]=fsub_s(P0[r],dl);P1[r]=fsub_s(P1[r],dl);} \
      cbm=cb-mhat; } \
    _Pragma("unroll") for(int r=0;r<16;++r)P0[r]=__builtin_amdgcn_exp2f(P0[r]); }while(0)
  #define RESC() do{ if(resc){ asm volatile("s_waitcnt lgkmcnt(0)":::"memory"); \
      _Pragma("unroll") for(int d_=0;d_<2;++d_) _Pragma("unroll") for(int r=0;r<16;++r)o[d_][r]*=wsf[crow(r,hi)]; } }while(0)
  f32x16 pA0,pA1,pB0,pB1;
  int sl_prev=0,sl_cur=0,sl_next=SLOTB;
  #define ROT() do{sl_prev=sl_cur;sl_cur=sl_next;sl_next=(sl_next==(NSLOT-1)*SLOTB)?0:sl_next+SLOTB;}while(0)
  DMA_K(2,2*SLOTB);
  WAIT_BAR(3);
  mkinit(pA0,pA1,mw,hi,cbm); MLOAD(mw,1); qkt(pA0,pA1,Kbase,qr,r32,hi);asm volatile("s_nop 15\n\ts_nop 7":"+v"(pA0),"+v"(pA1));CMASK(pA0,pA1,0,mw);
  START(pA0,pA1);
  _Pragma("unroll") for(int r=0;r<16;++r)pA1[r]=__builtin_amdgcn_exp2f(pA1[r]);
  WAIT_BAR(0);
  DMA_K(3,0);DMA_V(1,SLOTB);
  ROT();
  kload8(kf,kp0+sl_cur);
  WAIT_BAR(2);
  s16x4 vlo[8],vhi[8]; u32x4 pw0,pw1,pw2,pw3;
  #define PKW(P,B) cvtpk_s(P[B],P[B+1])
  #define PAF(k) __builtin_bit_cast(bf16x8,pw##k)
  #define VFR(i) (bf16x8){vlo[i][0],vlo[i][1],vlo[i][2],vlo[i][3],vhi[i][0],vhi[i][1],vhi[i][2],vhi[i][3]}
  #define PIN(x) asm volatile("":"+v"(x))
  #define MX3(a,b,c) __builtin_fmaxf(__builtin_fmaxf((a),(b)),(c))
  #define GAPA(MF,A0,A1,A2,A3,W0,W1,PW) do{ MF; sacc+=A0; sacc+=A1; sacc+=A2; sacc+=A3; PIN(sacc); W0; W1; PIN(PW); SBAR(); }while(0)
  #define EX(v) __builtin_amdgcn_exp2f(v)
  #define GAPB(MF,X,B) do{ MF; X[B]=EX(X[B]); X[B+1]=EX(X[B+1]); X[B+2]=EX(X[B+2]); X[B+3]=EX(X[B+3]); PIN(X); SBAR(); }while(0)
  #define VRD(i) do{ vlo[i]=vtr(vp_+(((i)>>2)*4096+((i)&3)*1024)); vhi[i]=vtr(vp_+(((i)>>2)*4096+((i)&3)*1024+512)); }while(0)
  #define KRD(G,j) do{ if(G){ kload2(kf,kp0+sl_next,j); SBAR(); } }while(0)
  #define STEP(C0,C1,P0,P1,t,GK,GV,GL,MWU,MWL) do{ SBAR(); mkinit(C0,C1,mw,hi,cbm); if(MWL){MLOAD(mw,(t)+1);} SBAR(); \
    const lds_cptr vp_=vp0+sl_prev; \
    VRD(0); SBAR(); float sacc=(P0[0]+P0[1]); \
    GAPA(C0=__builtin_amdgcn_mfma_f32_32x32x16_bf16(kf[0],qr[0],C0,0,0,1), P0[2],P0[3],P0[4],P0[5],     pw0[0]=PKW(P0,0), pw0[1]=PKW(P0,2), pw0); \
    VRD(4); SBAR(); GAPA(C1=__builtin_amdgcn_mfma_f32_32x32x16_bf16(kf[1],qr[0],C1,0,0,1), P0[6],P0[7],P0[8],P0[9],     pw0[2]=PKW(P0,4), pw0[3]=PKW(P0,6), pw0); \
    VRD(1); SBAR(); GAPA(C0=__builtin_amdgcn_mfma_f32_32x32x16_bf16(kf[2],qr[1],C0,0,0,1),   P0[10],P0[11],P0[12],P0[13], pw1[0]=PKW(P0,8), pw1[1]=PKW(P0,10), pw1); \
    VRD(5); SBAR(); GAPA(C1=__builtin_amdgcn_mfma_f32_32x32x16_bf16(kf[3],qr[1],C1,0,0,1),   P0[14],P0[15],P1[0],P1[1],   pw1[2]=PKW(P0,12),pw1[3]=PKW(P0,14), pw1); \
    VRD(2); SBAR(); GAPA(C0=__builtin_amdgcn_mfma_f32_32x32x16_bf16(kf[4],qr[2],C0,0,0,1),   P1[2],P1[3],P1[4],P1[5],     pw2[0]=PKW(P1,0), pw2[1]=PKW(P1,2), pw2); \
    VRD(6); SBAR(); GAPA(C1=__builtin_amdgcn_mfma_f32_32x32x16_bf16(kf[5],qr[2],C1,0,0,1),   P1[6],P1[7],P1[8],P1[9],     pw2[2]=PKW(P1,4), pw2[3]=PKW(P1,6), pw2); \
    VRD(3); SBAR(); GAPA(C0=__builtin_amdgcn_mfma_f32_32x32x16_bf16(kf[6],qr[3],C0,0,0,1),   P1[10],P1[11],P1[12],P1[13], pw3[0]=PKW(P1,8), pw3[1]=PKW(P1,10), pw3); \
    VRD(7); SBAR(); GAPA(C1=__builtin_amdgcn_mfma_f32_32x32x16_bf16(kf[7],qr[3],C1,0,0,1),   P1[14],P1[15],0.f,0.f,       pw3[2]=PKW(P1,12),pw3[3]=PKW(P1,14), pw3); \
    l_reg+=sacc; \
    if(GK){DMA_K((t)+3,sl_cur);} if(GV){DMA_V((t)+1,sl_next);} \
    CMASK(C0,C1,t,0); \
    { float a=MX3(C0[0],C0[1],C1[0]),b=MX3(C0[2],C0[3],C1[1]); a=MX3(a,C1[2],C1[3]); \
      _Pragma("unroll") for(int r=4;r<16;r+=4){a=MX3(a,C0[r],C0[r+1]);b=MX3(b,C0[r+2],C0[r+3]);a=MX3(a,C1[r],C1[r+1]);b=MX3(b,C1[r+2],C1[r+3]);} \
      float rm=__builtin_fmaxf(a,b); { auto rr=__builtin_amdgcn_permlane32_swap(__float_as_uint(rm),__float_as_uint(rm),false,false); rm=__builtin_fmaxf(__uint_as_float(rr[0]),__uint_as_float(rr[1])); } \
      resc=false; \
      if(__builtin_expect(__any(rm>(float)THRL),0)){ const float dl=__builtin_fmaxf(rm,0.f); mhat+=dl; \
        _Pragma("unroll") for(int r=0;r<16;++r){C0[r]-=dl;C1[r]-=dl;} \
        cbm=cb-mhat; \
        const float f=__builtin_amdgcn_exp2f(-dl); l_reg*=f; if(hi==0)wsf[r32]=f; resc=true; } } \
    SBAR(); \
    GAPB(o[0]=__builtin_amdgcn_mfma_f32_32x32x16_bf16(PAF(0),VFR(0),o[0],0,0,1), C0,0); \
    GAPB(o[1]=__builtin_amdgcn_mfma_f32_32x32x16_bf16(PAF(0),VFR(4),o[1],0,0,1), C0,4); \
    KRD(GL,0); GAPB(o[0]=__builtin_amdgcn_mfma_f32_32x32x16_bf16(PAF(1),VFR(1),o[0],0,0,1), C0,8); \
    KRD(GL,1); GAPB(o[1]=__builtin_amdgcn_mfma_f32_32x32x16_bf16(PAF(1),VFR(5),o[1],0,0,1), C0,12); \
    KRD(GL,2); GAPB(o[0]=__builtin_amdgcn_mfma_f32_32x32x16_bf16(PAF(2),VFR(2),o[0],0,0,1), C1,0); \
    KRD(GL,3); GAPB(o[1]=__builtin_amdgcn_mfma_f32_32x32x16_bf16(PAF(2),VFR(6),o[1],0,0,1), C1,4); \
    GAPB(o[0]=__builtin_amdgcn_mfma_f32_32x32x16_bf16(PAF(3),VFR(3),o[0],0,0,1), C1,8); \
    GAPB(o[1]=__builtin_amdgcn_mfma_f32_32x32x16_bf16(PAF(3),VFR(7),o[1],0,0,1), C1,12); \
    }while(0)
  int t=1;
  #undef CMASK
  #define CMASK(P0,P1,t,MW) do{}while(0)
  for(;t+7<NT;t+=2){
    STEP(pB0,pB1,pA0,pA1,t,true,true,true,0,1);     WAIT_BAR(2); RESC(); ROT();
    STEP(pA0,pA1,pB0,pB1,t+1,true,true,true,0,1);   WAIT_BAR(2); RESC(); ROT();
  }
  #undef CMASK
  #define CMASK(P0,P1,t,MW) do{ int jb2_=(t)-(NT-6); if(jb2_>=0)biasadd(P0,P1,tabA,q0+qrel-64*(t),hi); int jb_=(t)-(NT-4); if(jb_>=0)cmask(P0,P1,jb_,qrel,hi);}while(0)
  #define ENDW(tt) do{ if((tt)+3<NT){WAIT_BAR(2);} else if((tt)+2<NT){WAIT_BAR(1);} else {WAIT_BAR(0);} }while(0)
  for(;t+1<NT;t+=2){
    STEP(pB0,pB1,pA0,pA1,t,(t+3<NT),(t+1<NT),(t+1<NT),0,1);       ENDW(t);   RESC(); ROT();
    STEP(pA0,pA1,pB0,pB1,t+1,(t+4<NT),(t+2<NT),(t+2<NT),0,1);     ENDW(t+1); RESC(); ROT();
  }
  STEP(pB0,pB1,pA0,pA1,NT-1,false,false,false,0,0); RESC();
  { float sacc=pB0[0]+pB0[1]; _Pragma("unroll") for(int r=2;r<16;++r)sacc+=pB0[r]; _Pragma("unroll") for(int r=0;r<16;++r)sacc+=pB1[r]; l_reg+=sacc;
    pw0=(u32x4){PKW(pB0,0),PKW(pB0,2),PKW(pB0,4),PKW(pB0,6)};pw1=(u32x4){PKW(pB0,8),PKW(pB0,10),PKW(pB0,12),PKW(pB0,14)};pw2=(u32x4){PKW(pB1,0),PKW(pB1,2),PKW(pB1,4),PKW(pB1,6)};pw3=(u32x4){PKW(pB1,8),PKW(pB1,10),PKW(pB1,12),PKW(pB1,14)};
    SBAR(); pv(o,vb0+sl_cur,PAF(0),PAF(1),PAF(2),PAF(3)); }
  #undef PKW
  #undef PAF
  #undef VFR
  #undef PIN
  #undef MX3
  #undef GAPA
  #undef GAPB
  #undef EX
  #undef VRD
  #undef KRD
  #undef STEP
  #undef ENDW
  {auto rr=__builtin_amdgcn_permlane32_swap(__float_as_uint(l_reg),__float_as_uint(l_reg),false,false);l_reg=__uint_as_float(rr[0])+__uint_as_float(rr[1]);}
  if(hi==0)wsf[32+r32]=l_reg;asm volatile("s_waitcnt lgkmcnt(0)":::"memory");
  float rli[16];
  #pragma unroll
  for(int r=0;r<16;++r)rli[r]=__builtin_amdgcn_rcpf(wsf[32+crow(r,hi)]);
  bf16*Ow=O+(rowbase+q0+wid*QBLK)*DMO+h*D;
  { bf16*stg=(bf16*)(shm+LDS_OST)+wid*2048;
    #pragma unroll
    for(int r=0;r<16;++r){const int orow=crow(r,hi);
      #pragma unroll
      for(int d0=0;d0<2;++d0)stg[orow*64+d0*32+r32]=__float2bfloat16(o[d0][r]*rli[r]);}
    asm volatile("s_waitcnt lgkmcnt(0)":::"memory");
    #pragma unroll
    for(int i=0;i<4;++i){const int row=i*8+(lane>>3),ch=lane&7; const u32x4 v=*(const u32x4*)(stg+row*64+ch*8); ATTN_STORE16(Ow+(long)row*DMO+ch*8,v);} }
  asm volatile("s_waitcnt lgkmcnt(0)\n\ts_barrier":::"memory");
  #undef DMA_K
  #undef MROW
  #undef MLOAD
  #undef DMA_V
  #undef CMASK
  #undef START
  #undef RESC
  #undef ROT
}
constexpr int ATTN_LDS_BYTES=LDS_BYTES;
struct AttnTensors { const bf16* Q; const bf16* K; const bf16* V; bf16* O; const unsigned char* MSK; };
struct AttnUnit { int bh; int qb; };
struct StaticOrder {
  int vcu;
  __device__ __forceinline__ explicit StaticOrder(int grid,int block):vcu((block%8)*(grid/8)+block/8){}
  __device__ __forceinline__ bool next(int i,AttnUnit&u)const{ if(i>=2||vcu>=256)return false; const int s=vcu&15; u.bh=vcu>>4; u.qb=(i==0)?s:31-s; return true; }
  __device__ __forceinline__ void a_ready(const AttnUnit&)const{}
  __device__ __forceinline__ void done(const AttnUnit&)const{}
};
template<class Sched,int THRL=8> __device__ __forceinline__ void attn_phase(char*lds,int tid_in,const AttnTensors&T,const Sched&S,const __attribute__((address_space(3))) float*tabA,const __attribute__((address_space(3))) float*cbA){
  AttnUnit u;
  for(int i=0;S.next(i,u);++i){ S.a_ready(u); const int h_=u.bh%NHEAD; attn_unit<THRL>(u.bh/NHEAD,h_,u.qb,T.Q,T.K,T.V,T.O,lds,tid_in,T.MSK,tabA+h_*132,__builtin_bit_cast(float,__builtin_amdgcn_readfirstlane(__builtin_bit_cast(int,cbA[h_])))); S.done(u); }
}
#undef SBAR
#undef WAIT_BAR
}
constexpr int NTOK = 16384, DMOD = 1024, SEQL = 8192, PP = 5120, NLAYER = 2;
constexpr float DN_ALPHA = 1.4142135623730951f;
constexpr float LN_EPS_ = 1e-5f, RMS_EPS_ = 1e-6f;
constexpr float LOG2E = 1.4426950408889634f;
constexpr int MOE_MAXSLOT = 40960, MOE_MAXBLK = 160;
constexpr int PC_AQ = 0, PC_AK = 512, PC_AV = 1024, PC_IQ = 1536, PC_IK = 2048, PC_IW = 2112, PC_BQ = 2304, PC_BI = 3328, PC_BG = 3840, PC_CQ = 4352, PC_CK = 4864, PC_CV = 4992;

constexpr size_t MiB = 1u << 20;
constexpr size_t WS_CTL = 0, WS_FF = 1 * MiB;
constexpr size_t WS_WIN = 2 * MiB, WS_WBR = 34 * MiB, WS_WOUT = 40 * MiB, WS_XWQ = 44 * MiB, WS_XWKV = 48 * MiB, WS_XWO = 56 * MiB;
constexpr size_t WS_MEMB = 60 * MiB, WS_XK = 61 * MiB, WS_XVT = 63 * MiB, WS_MISC = 65 * MiB;
constexpr size_t MISC_LB = 0, MISC_WR = 8192, MISC_EXPI = 512 * 1024, MISC_GW = 768 * 1024, MISC_BLKE = 1024 * 1024, MISC_PCNT = 1024 * 1024 + 8192;
constexpr size_t WS_HB = 68 * MiB;
constexpr size_t WS_P = 100 * MiB;
constexpr size_t WS_T = WS_P, WS_XQ = WS_P + 64 * MiB, WS_XO = WS_P + 96 * MiB, WS_XS = WS_P, WS_HID = WS_P + 80 * MiB;
constexpr size_t WS_Q = 260 * MiB;
constexpr size_t WS_YA = WS_Q, WS_YB = WS_Q + 16 * MiB, WS_YC = WS_Q + 32 * MiB, WS_SC = WS_Q + 48 * MiB, WS_MSK = WS_Q + 178 * MiB, WS_LOGF = WS_Q + 194 * MiB;
constexpr size_t WS_HGL = WS_Q + 226 * MiB, WS_HGS = WS_Q + 242 * MiB, WS_HGD = WS_Q + 258 * MiB, WS_CVT = WS_Q + 259 * MiB, WS_END = WS_Q + 263 * MiB;
constexpr size_t WS_GATE = WS_SC, WS_MERGED = WS_SC + 96 * MiB, WS_MRG = WS_MSK;
constexpr size_t WS_MW13 = WS_SC, WS_MW2 = WS_SC + 64 * MiB, WS_YASG = WS_SC + 96 * MiB;
constexpr size_t SC_BATCH = (size_t)128 * 128 * 2080;
constexpr int CW_TMO = 0, CW_BAR = 4096, CW_CNT = 8192, CW_CUR = 8192 + 256, CW_NBLK = 8192 + 512;

constexpr int LDS_BYTES = 163840, LDS_PERS = 148480;
constexpr int LP_MISC = LDS_PERS, LP_TABA = LDS_PERS + 256, LP_TABC = LP_TABA + 8 * 132 * 4, LP_CBA = LP_TABC + 8 * 128 * 4, LP_SINK = LP_CBA + 32, LP_PTRS = LP_SINK + 64, LP_END = LP_PTRS + 21 * 8;
static_assert(LP_END <= LDS_BYTES, "LDS map");

#define GAS __attribute__((address_space(1)))
#define LAS __attribute__((address_space(3)))
typedef unsigned short bf16;
typedef unsigned v4u __attribute__((ext_vector_type(4)));
typedef unsigned v2u __attribute__((ext_vector_type(2)));
typedef float f32x4 __attribute__((ext_vector_type(4)));
typedef float f32x16 __attribute__((ext_vector_type(16)));
typedef short bf16x8 __attribute__((ext_vector_type(8)));
typedef short s16x4 __attribute__((ext_vector_type(4)));
typedef GAS unsigned gu32;
#define RLX_AGENT __ATOMIC_RELAXED, __HIP_MEMORY_SCOPE_AGENT
#define LDS_WAIT() asm volatile("s_waitcnt lgkmcnt(0)" ::: "memory")
__device__ __forceinline__ unsigned f2bf(float f) { unsigned u = __builtin_bit_cast(unsigned, f); return (u + 0x7fffu + ((u >> 16) & 1u)) >> 16; }
__device__ __forceinline__ unsigned pk2(float lo, float hi) { return f2bf(lo) | (f2bf(hi) << 16); }
__device__ __forceinline__ float bf2f(unsigned short b) { return __uint_as_float((unsigned)b << 16); }
__device__ __forceinline__ float bflo(unsigned w) { return __uint_as_float(w << 16); }
__device__ __forceinline__ float bfhi(unsigned w) { return __uint_as_float(w & 0xffff0000u); }
__device__ __forceinline__ int crow16(int r, int hi) { return (r & 3) + 8 * (r >> 2) + 4 * hi; }
__device__ __forceinline__ bf16x8 cat44(s16x4 a, s16x4 b) { return (bf16x8){a[0], a[1], a[2], a[3], b[0], b[1], b[2], b[3]}; }
__device__ __forceinline__ float xhalf_max(float v) { auto rr = __builtin_amdgcn_permlane32_swap(__float_as_uint(v), __float_as_uint(v), false, false); return fmaxf(__uint_as_float(rr[0]), __uint_as_float(rr[1])); }
__device__ __forceinline__ float xhalf_sum(float v) { auto rr = __builtin_amdgcn_permlane32_swap(__float_as_uint(v), __float_as_uint(v), false, false); return __uint_as_float(rr[0]) + __uint_as_float(rr[1]); }
__device__ __forceinline__ int dpp_row_sum_i(int v) {
    v += __builtin_amdgcn_update_dpp(0, v, 0xB1, 0xF, 0xF, true);
    v += __builtin_amdgcn_update_dpp(0, v, 0x4E, 0xF, 0xF, true);
    v += __builtin_amdgcn_update_dpp(0, v, 0x141, 0xF, 0xF, true);
    v += __builtin_amdgcn_update_dpp(0, v, 0x140, 0xF, 0xF, true);
    return v;
}
__device__ __forceinline__ float dpp_row_sum_f(float v) {
    v += __builtin_bit_cast(float, __builtin_amdgcn_update_dpp(0, __builtin_bit_cast(int, v), 0xB1, 0xF, 0xF, true));
    v += __builtin_bit_cast(float, __builtin_amdgcn_update_dpp(0, __builtin_bit_cast(int, v), 0x4E, 0xF, 0xF, true));
    v += __builtin_bit_cast(float, __builtin_amdgcn_update_dpp(0, __builtin_bit_cast(int, v), 0x141, 0xF, 0xF, true));
    v += __builtin_bit_cast(float, __builtin_amdgcn_update_dpp(0, __builtin_bit_cast(int, v), 0x140, 0xF, 0xF, true));
    return v;
}
__device__ __forceinline__ int wave_sum_i(int v) {
    v = dpp_row_sum_i(v);
    v += __builtin_amdgcn_update_dpp(0, v, 0x142, 0xA, 0xF, false);
    v += __builtin_amdgcn_update_dpp(0, v, 0x143, 0xC, 0xF, false);
    return __builtin_amdgcn_readlane(v, 63);
}
__device__ __forceinline__ float wave_sum(float v) {
    v = dpp_row_sum_f(v);
    v += __builtin_bit_cast(float, __builtin_amdgcn_update_dpp(0, __builtin_bit_cast(int, v), 0x142, 0xA, 0xF, false));
    v += __builtin_bit_cast(float, __builtin_amdgcn_update_dpp(0, __builtin_bit_cast(int, v), 0x143, 0xC, 0xF, false));
    return __builtin_bit_cast(float, __builtin_amdgcn_readlane(__builtin_bit_cast(int, v), 63));
}
#define MFMA32(a, b, c) __builtin_amdgcn_mfma_f32_32x32x16_bf16((a), (b), (c), 0, 0, 0)
#define XB_TMO      128
#define XB_XCNT(j)  (256  + 64 * (j))
#define XB_XSUB(j)  (1280 + 64 * (j))
#define XB_XGEN(j)  (2304 + 64 * (j))
#define XB_TOP      3328
#define XB_TOPGEN   3392
#define XCD_BAR_WORDS 3456
#define XB_SPIN_CAP (1u << 18)

__device__ __forceinline__ unsigned xb_ld(unsigned* p)              { return __hip_atomic_load(p, __ATOMIC_RELAXED, __HIP_MEMORY_SCOPE_AGENT); }
__device__ __forceinline__ unsigned xb_add(unsigned* p, unsigned v) { return __hip_atomic_fetch_add(p, v, __ATOMIC_RELAXED, __HIP_MEMORY_SCOPE_AGENT); }
__device__ __forceinline__ unsigned xb_xcc_id() { return (unsigned)__builtin_amdgcn_s_getreg((3 << 11) | 20) & 0xFu; }
#define XB_SPIN(cond, bar) do { unsigned _sp = 0; while (cond) { __builtin_amdgcn_s_sleep(1); \
    if ((++_sp & 255u) == 0u) { if (xb_ld(&(bar)[XB_TMO])) break; if (_sp > XB_SPIN_CAP) { atomicAdd(&(bar)[XB_TMO], 1u); break; } } } } while (0)

struct XcdBarrier {
    unsigned* bar; unsigned x;
    volatile LAS unsigned* st;
};

__device__ __forceinline__ XcdBarrier xcd_barrier_post(unsigned* bar, volatile LAS unsigned* st) {
    XcdBarrier b; b.bar = bar; b.x = xb_xcc_id(); b.st = st;
    if (threadIdx.x == 0) (void)xb_add(&bar[XB_XCNT(b.x)], 1u);
    return b;
}
__device__ __forceinline__ void xcd_barrier_complete(unsigned* bar, unsigned x, unsigned& nloc, unsigned& nx) {
    const unsigned G = gridDim.x * gridDim.y * gridDim.z;
    unsigned sum, cnt, mine, sp = 0u;
    for (;;) {
        sum = 0u; cnt = 0u; mine = 0u;
#pragma unroll
        for (unsigned j = 0; j < 16; ++j) { const unsigned c = xb_ld(&bar[XB_XCNT(j)]); sum += c; cnt += (c > 0u) ? 1u : 0u; mine = (j == x) ? c : mine; }
        if (sum == G) break;
        __builtin_amdgcn_s_sleep(1);
        if ((++sp & 255u) == 0u) { if (xb_ld(&bar[XB_TMO])) break; if (sp > XB_SPIN_CAP) { atomicAdd(&bar[XB_TMO], 1u); break; } }
    }
    nloc = mine > 0u ? mine : 1u; nx = cnt > 0u ? cnt : 1u;
}

__device__ __noinline__ void xcd_barrier(const XcdBarrier b, const bool leader) {
    asm volatile("s_waitcnt vmcnt(0)" ::: "memory");
    __syncthreads();
    if (leader) {
        unsigned* bar = b.bar;
        __builtin_amdgcn_s_waitcnt(0);
        unsigned nloc = b.st[0], nx = b.st[1];
        if (nloc == 0u) { xcd_barrier_complete(bar, b.x, nloc, nx); b.st[0] = nloc; b.st[1] = nx; }
        const unsigned old = xb_add(&bar[XB_XSUB(b.x)], 1u);
        const unsigned gen = old / nloc;
        if (old + 1u == (gen + 1u) * nloc) {
            __builtin_amdgcn_fence(__ATOMIC_RELEASE, "agent");
            asm volatile("s_waitcnt vmcnt(0)" ::: "memory");
            const unsigned og = xb_add(&bar[XB_TOP], 1u);
            const unsigned tg = og / nx;
            if (og + 1u == (tg + 1u) * nx) xb_add(&bar[XB_TOPGEN], 1u);
            else XB_SPIN(xb_ld(&bar[XB_TOPGEN]) == tg, bar);
            __builtin_amdgcn_fence(__ATOMIC_ACQUIRE, "agent");
            xb_add(&bar[XB_XGEN(b.x)], 1u);
            asm volatile("s_waitcnt vmcnt(0)" ::: "memory");
        } else {
            XB_SPIN(xb_ld(&bar[XB_XGEN(b.x)]) == gen, bar);
            __builtin_amdgcn_fence(__ATOMIC_ACQUIRE, "agent");
            asm volatile("s_waitcnt vmcnt(0)" ::: "memory");
        }
    }
    __syncthreads();
}
struct Frame {
    LAS unsigned char* lds;
    gu32* ctl;
    unsigned char* ws;
    int tid, lane, wave, wave0, vcu, G;
    struct InTab { const LAS unsigned* p;
        __device__ __forceinline__ const float* operator[](int i) const { const unsigned lo = (unsigned)__builtin_amdgcn_readfirstlane((int)p[2 * i]), hi = (unsigned)__builtin_amdgcn_readfirstlane((int)p[2 * i + 1]);
            return (const float*)(const GAS float*)(((unsigned long long)hi << 32) | (unsigned long long)lo); } } in;
    float* out;
};
enum { I_X = 0, I_MEM, I_RELB, I_WIN, I_WBR, I_WOUT, I_LB, I_NG, I_SINK, I_XWQ, I_XWKV, I_XWO, I_WG, I_BG, I_WE, I_BE, I_W1, I_W3, I_W2, I_LNG, I_LNB };

__device__ __forceinline__ unsigned long long launder64(unsigned long long v) { int lo = __builtin_amdgcn_readfirstlane((int)(unsigned)v), hi = __builtin_amdgcn_readfirstlane((int)(unsigned)(v >> 32)); asm volatile("" : "+s"(lo), "+s"(hi)); return ((unsigned long long)(unsigned)hi << 32) | (unsigned)lo; }
#define PHASE_ENTER(F) do { (F).ws = (unsigned char*)(GAS unsigned char*)launder64((unsigned long long)(F).ws); (F).out = (float*)(GAS float*)launder64((unsigned long long)(F).out); (F).ctl = (gu32*)((F).ws + WS_CTL); \
    (F).lane = lane_now(); (F).wave = __builtin_amdgcn_readfirstlane((F).wave0); (F).tid = (F).wave * 64 + (F).lane; } while (0)
__device__ __forceinline__ void tr_item(const float* W, int K, int N, bf16* WT, int kb, int nb, int rowbase, int thresh, int add, LAS float* scr, int lane) {
    const int k0 = 64 * kb, n0 = 32 * nb; const int ncol = n0 + (lane & 31);
    float tv[32];
#pragma unroll
    for (int i = 0; i < 32; ++i) { const int kk = 2 * i + (lane >> 5); tv[i] = (ncol < N) ? W[(size_t)(k0 + kk) * N + ncol] : 0.f; }
#pragma unroll
    for (int i = 0; i < 32; ++i) { const int kk = 2 * i + (lane >> 5); scr[kk * 33 + (lane & 31)] = tv[i]; }
    LDS_WAIT(); asm volatile("" ::: "memory");
    const int c = lane & 7;
#pragma unroll
    for (int j = 0; j < 4; ++j) { const int n = (lane >> 3) + 8 * j; const LAS float* s = scr + (8 * c) * 33 + n; const int o = n0 + n;
        v4u w; w.x = pk2(s[0 * 33], s[1 * 33]); w.y = pk2(s[2 * 33], s[3 * 33]); w.z = pk2(s[4 * 33], s[5 * 33]); w.w = pk2(s[6 * 33], s[7 * 33]);
        if (o < N) *(GAS v4u*)(WT + (size_t)(rowbase + o + (o >= thresh ? add : 0)) * K + k0 + 8 * c) = w; }
    LDS_WAIT(); asm volatile("" ::: "memory");
}
__device__ __forceinline__ void cvt_rows(Frame& F, const float* src, bf16* dst, size_t n8) {
    const size_t gt = (size_t)F.vcu * 512 + F.tid, NT = (size_t)F.G * 512;
    for (size_t i = gt; i < n8; i += NT) { const f32x4 a = *(const GAS f32x4*)(src + i * 8), b = *(const GAS f32x4*)(src + i * 8 + 4);
        v4u w; w.x = pk2(a.x, a.y); w.y = pk2(a.z, a.w); w.z = pk2(b.x, b.y); w.w = pk2(b.z, b.w); *(GAS v4u*)(dst + i * 8) = w; }
}
__device__ __forceinline__ void ph_prologue(Frame& F) {
    LAS float* scr = (LAS float*)(F.lds + F.wave * 16384);
    const int gw = F.vcu * 8 + F.wave, NGW = F.G * 8;
    constexpr int I_IN = 16 * 251, I_BR = 8 * 32, I_SQ = 16 * 32, I_KV = 16 * 64;
    constexpr int PER_L = I_IN + 3 * I_BR + I_SQ + I_SQ + I_KV + I_SQ;
    for (int it = gw; it < 2 * PER_L; it += NGW) {
        const int l = it / PER_L; int r = it % PER_L;
        if (r < I_IN) { tr_item(F.in[I_WIN] + (size_t)l * 1024 * 8008, 1024, 8008, (bf16*)(F.ws + WS_WIN) + (size_t)l * 8192 * 1024, r / 251, r % 251, 0, 2120, 184, scr, F.lane); continue; } r -= I_IN;
        if (r < 3 * I_BR) { const int g = r / I_BR, q = r % I_BR; tr_item(F.in[I_WBR] + (size_t)(l * 3 + g) * 512 * 1024, 512, 1024, (bf16*)(F.ws + WS_WBR) + (size_t)(l * 3 + g) * 1024 * 512, q / 32, q % 32, 0, 1 << 30, 0, scr, F.lane); continue; } r -= 3 * I_BR;
        if (r < I_SQ) { tr_item(F.in[I_WOUT] + (size_t)l * 1024 * 1024, 1024, 1024, (bf16*)(F.ws + WS_WOUT) + (size_t)l * 1024 * 1024, r / 32, r % 32, 0, 1 << 30, 0, scr, F.lane); continue; } r -= I_SQ;
        if (r < I_SQ) { tr_item(F.in[I_XWQ] + (size_t)l * 1024 * 1024, 1024, 1024, (bf16*)(F.ws + WS_XWQ) + (size_t)l * 1024 * 1024, r / 32, r % 32, 0, 1 << 30, 0, scr, F.lane); continue; } r -= I_SQ;
        if (r < I_KV) { tr_item(F.in[I_XWKV] + (size_t)l * 1024 * 2048, 1024, 2048, (bf16*)(F.ws + WS_XWKV) + (size_t)l * 2048 * 1024, r / 64, r % 64, 0, 1 << 30, 0, scr, F.lane); continue; } r -= I_KV;
        tr_item(F.in[I_XWO] + (size_t)l * 1024 * 1024, 1024, 1024, (bf16*)(F.ws + WS_XWO) + (size_t)l * 1024 * 1024, r / 32, r % 32, 0, 1 << 30, 0, scr, F.lane);
    }
    { const size_t gt = (size_t)F.vcu * 512 + F.tid, NT = (size_t)F.G * 512; constexpr size_t PADV = (size_t)184 * 1024 / 8;
      for (size_t i = gt; i < 2 * PADV; i += NT) { const size_t l = i / PADV, j = i % PADV; *(GAS v4u*)((bf16*)(F.ws + WS_WIN) + l * 8192 * 1024 + (size_t)2120 * 1024 + j * 8) = (v4u){0u, 0u, 0u, 0u}; } }
    { const int gt = F.vcu * 512 + F.tid, NT = F.G * 512; int* SA = (int*)(F.ws + WS_FF); for (int i = gt; i < 2 * MOE_MAXSLOT; i += NT) SA[i] = -1; }
    cvt_rows(F, F.in[I_X], (bf16*)(F.ws + WS_HB), (size_t)NTOK * DMOD / 8);
    cvt_rows(F, F.in[I_MEM], (bf16*)(F.ws + WS_MEMB), (size_t)512 * 1024 / 8);
    { const int gt = F.vcu * 512 + F.tid, NT = F.G * 512; float* LB = (float*)(F.ws + WS_MISC + MISC_LB);
      for (int c = gt; c < 512; c += NT) { const float v0 = F.in[I_LB][c], v1 = F.in[I_LB][512 + c], m = fmaxf(v0, v1), e0 = expf(v0 - m), e1 = expf(v1 - m); const float s1 = e1 / (e0 + e1);
          LB[c] = 1e-30f; LB[512 + c] = fminf(fmaxf(s1, 1e-30f), 1.0f - 1e-6f); }
      float* WR = (float*)(F.ws + WS_MISC + MISC_WR);
      for (int i = gt; i < 2 * 36 * 1024; i += NT) { const int l = i / (36 * 1024), r = i % (36 * 1024), n = r / 1024, k = r % 1024;
          WR[(size_t)(l * 36 + n) * 1028 + k] = (n < 4) ? F.in[I_WG][(size_t)l * 1024 * 4 + k * 4 + n] : F.in[I_WE][(size_t)l * 1024 * 32 + k * 32 + (n - 4)]; } }
}
__device__ __forceinline__ void ph_moe_convert(Frame& F, int l) {
    LAS float* scr = (LAS float*)(F.lds + F.wave * 16384);
    const int gw = F.vcu * 8 + F.wave, NGW = F.G * 8;
    bf16* W13 = (bf16*)(F.ws + WS_MW13); bf16* W2 = (bf16*)(F.ws + WS_MW2);
    for (int it = gw; it < 32 * 768; it += NGW) {
        const int e = it / 768; int r = it % 768;
        if (r < 512) { const int w3 = r >> 8, q = r & 255, kb = q / 16, nb = q % 16, n0 = 32 * nb;
            const float* W = F.in[w3 ? I_W3 : I_W1] + ((size_t)l * 32 + e) * 1024 * 512;
            tr_item(W, 1024, 512, W13, kb, nb, e * 1024 + 256 * (n0 >> 7) + 128 * w3 + (n0 & 127) - n0, 1 << 30, 0, scr, F.lane); }
        else { const int q = r - 512, kb = q / 32, nb = q % 32;
            tr_item(F.in[I_W2] + ((size_t)l * 32 + e) * 512 * 1024, 512, 1024, W2, kb, nb, e * 1024, 1 << 30, 0, scr, F.lane); }
    }
}

template <int MODE> __device__ __forceinline__ void ph_ln(Frame& F, int l, int which, const float* Hin) {
    const float* lng = F.in[I_LNG] + (size_t)(l * 3 + which) * 1024; const float* lnb = F.in[I_LNB] + (size_t)(l * 3 + which) * 1024;
    const float* T = (const float*)(F.ws + WS_T); bf16* HB = (bf16*)(F.ws + WS_HB);
    LAS float* WRL = (LAS float*)F.lds; LAS unsigned* LCNT = (LAS unsigned*)(F.lds + 148032);
    if (MODE == 1) {
        const float* WR = (const float*)(F.ws + WS_MISC + MISC_WR) + (size_t)l * 36 * 1028;
        for (int i = F.tid; i < 36 * 1028 / 4; i += 512) ((LAS f32x4*)WRL)[i] = ((const GAS f32x4*)WR)[i];
        if (F.tid < 32) LCNT[F.tid] = 0u;
        __syncthreads();
    }
    f32x4 gv[4], bv[4];
#pragma unroll
    for (int j = 0; j < 4; ++j) { gv[j] = *(const GAS f32x4*)(lng + 256 * j + 4 * F.lane); bv[j] = *(const GAS f32x4*)(lnb + 256 * j + 4 * F.lane); }
    float rbias = 0.f;
    if (MODE == 1) rbias = (F.lane < 4) ? F.in[I_BG][l * 4 + F.lane] : ((F.lane < 36) ? F.in[I_BE][l * 32 + F.lane - 4] : 0.f);
    const int gw = F.vcu * 8 + F.wave, NGW = F.G * 8;
    for (int m0 = gw * 4; m0 < NTOK; m0 += NGW * 4) {
        f32x4 v[4][4];
#pragma unroll
        for (int r = 0; r < 4; ++r) { const size_t row = (size_t)(m0 + r);
            if (MODE == 2) {
                const float* gwp = (const float*)(F.ws + WS_MISC + MISC_GW) + row * 2; const float g0 = gwp[0], g1 = gwp[1];
                const bf16* y0 = (const bf16*)(F.ws + WS_YASG) + row * 2 * 1024, *y1 = y0 + 1024;
#pragma unroll
                for (int j = 0; j < 4; ++j) { const f32x4 hv = *(const GAS f32x4*)(Hin + row * 1024 + 256 * j + 4 * F.lane);
                    const v2u a = *(const GAS v2u*)(y0 + 256 * j + 4 * F.lane), b = *(const GAS v2u*)(y1 + 256 * j + 4 * F.lane);
                    v[r][j].x = DN_ALPHA * hv.x + g0 * bflo(a.x) + g1 * bflo(b.x); v[r][j].y = DN_ALPHA * hv.y + g0 * bfhi(a.x) + g1 * bfhi(b.x);
                    v[r][j].z = DN_ALPHA * hv.z + g0 * bflo(a.y) + g1 * bflo(b.y); v[r][j].w = DN_ALPHA * hv.w + g0 * bfhi(a.y) + g1 * bfhi(b.y); }
            } else {
#pragma unroll
                for (int j = 0; j < 4; ++j) v[r][j] = *(const GAS f32x4*)(T + row * 1024 + 256 * j + 4 * F.lane);
            }
            float s = 0.f;
#pragma unroll
            for (int j = 0; j < 4; ++j) s += (v[r][j].x + v[r][j].y) + (v[r][j].z + v[r][j].w);
            const float mean = wave_sum(s) * (1.f / 1024.f); float s2 = 0.f;
#pragma unroll
            for (int j = 0; j < 4; ++j) { v[r][j] = v[r][j] - mean; s2 += (v[r][j].x * v[r][j].x + v[r][j].y * v[r][j].y) + (v[r][j].z * v[r][j].z + v[r][j].w * v[r][j].w); }
            const float rstd = 1.f / sqrtf(wave_sum(s2) * (1.f / 1024.f) + LN_EPS_);
#pragma unroll
            for (int j = 0; j < 4; ++j) { v[r][j] = v[r][j] * rstd * gv[j] + bv[j];
                *(GAS f32x4*)(F.out + row * 1024 + 256 * j + 4 * F.lane) = v[r][j];
                v2u w; w.x = pk2(v[r][j].x, v[r][j].y); w.y = pk2(v[r][j].z, v[r][j].w); *(GAS v2u*)(HB + row * 1024 + 256 * j + 4 * F.lane) = w; }
        }
        if (MODE == 1) {
            float lg[4] = {0.f, 0.f, 0.f, 0.f};
#pragma unroll 1
            for (int n = 0; n < 36; ++n) {
                f32x4 wv[4];
#pragma unroll
                for (int j = 0; j < 4; ++j) wv[j] = *(const LAS f32x4*)(WRL + n * 1028 + 256 * j + 4 * F.lane);
#pragma unroll
                for (int r = 0; r < 4; ++r) { float p = 0.f;
#pragma unroll
                    for (int j = 0; j < 4; ++j) p += (v[r][j].x * wv[j].x + v[r][j].y * wv[j].y) + (v[r][j].z * wv[j].z + v[r][j].w * wv[j].w);
                    p = wave_sum(p); lg[r] = (F.lane == n) ? p : lg[r]; }
            }
#pragma unroll
            for (int r = 0; r < 4; ++r) {
                const float x = lg[r] + rbias;
                float gl[4];
#pragma unroll
                for (int i = 0; i < 4; ++i) gl[i] = __int_as_float(__builtin_amdgcn_readlane(__float_as_int(x), i));
                int grp = 0; float gm = gl[0];
#pragma unroll
                for (int i = 1; i < 4; ++i) if (gl[i] > gm) { gm = gl[i]; grp = i; }
                float den = 0.f;
#pragma unroll
                for (int i = 0; i < 4; ++i) den += expf(gl[i] - gm);
                const float pg = 1.0f / den;
                grp = __builtin_amdgcn_readfirstlane(grp);
                float ev[8];
#pragma unroll
                for (int e = 0; e < 8; ++e) ev[e] = __int_as_float(__builtin_amdgcn_readlane(__float_as_int(x), 4 + grp * 8 + e));
                int i1 = 0; float v1 = ev[0];
#pragma unroll
                for (int e = 1; e < 8; ++e) if (ev[e] > v1) { v1 = ev[e]; i1 = e; }
                int i2 = -1; float v2 = -INFINITY;
#pragma unroll
                for (int e = 0; e < 8; ++e) if (e != i1 && ev[e] > v2) { v2 = ev[e]; i2 = e; }
                const float ea = 1.0f / (1.0f + expf(v2 - v1));
                if (F.lane == 0) { const size_t row = (size_t)(m0 + r);
                    int* ex = (int*)(F.ws + WS_MISC + MISC_EXPI) + row * 2; float* gwp = (float*)(F.ws + WS_MISC + MISC_GW) + row * 2;
                    const int e1 = grp * 8 + i1, e2 = grp * 8 + i2;
                    ex[0] = e1; ex[1] = e2; gwp[0] = ea * pg; gwp[1] = (1.0f - ea) * pg;
                    __hip_atomic_fetch_add(LCNT + e1, 1u, __ATOMIC_RELAXED, __HIP_MEMORY_SCOPE_WORKGROUP); __hip_atomic_fetch_add(LCNT + e2, 1u, __ATOMIC_RELAXED, __HIP_MEMORY_SCOPE_WORKGROUP); }
            }
        }
    }
    if (MODE == 1) {
        __syncthreads();
        if (F.tid < 32) ((unsigned*)(F.ws + WS_MISC + MISC_PCNT))[F.vcu * 32 + F.tid] = LCNT[F.tid];
    }
}

__device__ __forceinline__ void ph_slots(Frame& F, int l) {
    LAS int* PADS = (LAS int*)F.lds; LAS int* BASE = (LAS int*)(F.lds + 256); LAS int* EXPL = (LAS int*)(F.lds + 512); LAS int* SLOTOF = (LAS int*)(F.lds + 1024); LAS int* PART = (LAS int*)(F.lds + 2048);
    int* BLKE = (int*)(F.ws + WS_MISC + MISC_BLKE) + l * 256; int* SLOT_ASG = (int*)(F.ws + WS_FF) + l * MOE_MAXSLOT;
    const int* EXPI = (const int*)(F.ws + WS_MISC + MISC_EXPI); const unsigned* PCNT = (const unsigned*)(F.ws + WS_MISC + MISC_PCNT);
    if (F.vcu >= NTOK / 64) return;
    { const int e = F.tid & 31, part = F.tid >> 5; int tot = 0, bas = 0;
#pragma unroll 4
      for (int v = part * 16; v < part * 16 + 16; ++v) { const int c = (int)PCNT[v * 32 + e]; tot += c; bas += (v < F.vcu) ? c : 0; }
      PART[(part * 32 + e) * 2] = tot; PART[(part * 32 + e) * 2 + 1] = bas; }
    __syncthreads();
    if (F.tid < 32) { int tot = 0, bas = 0;
#pragma unroll 1
        for (int q = 0; q < 16; ++q) { tot += PART[(q * 32 + F.tid) * 2]; bas += PART[(q * 32 + F.tid) * 2 + 1]; }
        BASE[F.tid] = bas; EXPL[F.tid] = tot; }
    __syncthreads();
    if (F.tid == 0) { int acc = 0;
#pragma unroll 1
        for (int e = 0; e < 32; ++e) { PADS[e] = acc; acc += ((EXPL[e] + 255) >> 8) << 8; }
        PADS[32] = acc;
        if (blockIdx.x == 0) __hip_atomic_store(F.ctl + CW_NBLK + l * 64, (unsigned)(acc >> 8), RLX_AGENT); }
    __syncthreads();
    if (blockIdx.x == 0 && F.tid < MOE_MAXBLK) { const int s0 = F.tid << 8;
        if (s0 < PADS[32]) { int e = 0;
#pragma unroll 1
            for (int q = 1; q < 32; ++q) if (PADS[q] <= s0) e = q;
            BLKE[F.tid] = e; } }
    __syncthreads();
    int e = 0, tok = 0, k = 0;
    if (F.tid < 128) { const int r = F.tid >> 1; tok = (r < 32) ? 32 * F.vcu + r : 8192 + 32 * F.vcu + (r - 32); k = F.tid & 1; e = EXPI[tok * 2 + k]; EXPL[F.tid] = e; }
    __syncthreads();
    if (F.tid < 128) { int rank = 0;
#pragma unroll 1
        for (int a = 0; a < F.tid; ++a) rank += (EXPL[a] == e) ? 1 : 0;
        const int slot = PADS[e] + BASE[e] + rank; SLOTOF[F.tid] = slot; SLOT_ASG[slot] = tok * 2 + k; }
    __syncthreads();
    for (int a = F.wave; a < 128; a += 8) { const int slot = SLOTOF[a]; const int r = a >> 1; const int tk = (r < 32) ? 32 * F.vcu + r : 8192 + 32 * F.vcu + (r - 32);
        const GAS v4u* src = (const GAS v4u*)((const bf16*)(F.ws + WS_HB) + (size_t)tk * 1024); GAS v4u* dst = (GAS v4u*)((bf16*)(F.ws + WS_XS) + (size_t)slot * 1024);
        dst[F.lane] = src[F.lane]; dst[64 + F.lane] = src[64 + F.lane]; }
}
__device__ __forceinline__ size_t sc_row_off(int b, int t) { const int qb = t >> 7; return (size_t)b * SC_BATCH + (size_t)16384 * (size_t)(qb * (qb + 1) / 2) + (size_t)(t & 127) * (size_t)(128 * (qb + 1)); }
__device__ __forceinline__ void ph_indexer(Frame& F) {
    const bf16* P = (const bf16*)(F.ws + WS_P); unsigned short* SC = (unsigned short*)(F.ws + WS_SC);
    const int r32 = F.lane & 31, hi = F.lane >> 5;
    for (int u = F.vcu; u < 256; u += F.G) {
        const int b = u >> 7, p = u & 127;
#pragma unroll 1
        for (int gi = 0; gi < 2; ++gi) {
            const int g = gi ? 255 - p : p, t0 = 32 * g, t = t0 + r32;
            const bf16* qrow = P + (size_t)(b * SEQL + t) * PP;
            bf16x8 qf[8][4];
#pragma unroll
            for (int h = 0; h < 8; ++h)
#pragma unroll
                for (int ks = 0; ks < 4; ++ks) qf[h][ks] = *(const GAS bf16x8*)(qrow + PC_IQ + h * 64 + ks * 16 + hi * 8);
            float w[8];
            { const v4u ww = *(const GAS v4u*)(qrow + PC_IW); const float sc = 0.35355339059327373f * 0.125f;
              w[0] = bflo(ww.x) * sc; w[1] = bfhi(ww.x) * sc; w[2] = bflo(ww.y) * sc; w[3] = bfhi(ww.y) * sc; w[4] = bflo(ww.z) * sc; w[5] = bfhi(ww.z) * sc; w[6] = bflo(ww.w) * sc; w[7] = bfhi(ww.w) * sc; }
            unsigned short* srow = SC + sc_row_off(b, t);
#pragma unroll 1
            for (int kt = F.wave; kt <= g; kt += 8) {
                const bf16* krow = P + (size_t)(b * SEQL + 32 * kt + r32) * PP + PC_IK + hi * 8;
                bf16x8 kf[4];
#pragma unroll
                for (int ks = 0; ks < 4; ++ks) kf[ks] = *(const GAS bf16x8*)(krow + ks * 16);
                f32x16 sc;
#pragma unroll
                for (int r = 0; r < 16; ++r) sc[r] = 0.f;
#pragma unroll
                for (int h = 0; h < 8; ++h) {
                    f32x16 acc;
#pragma unroll
                    for (int r = 0; r < 16; ++r) acc[r] = 0.f;
#pragma unroll
                    for (int ks = 0; ks < 4; ++ks) acc = MFMA32(kf[ks], qf[h][ks], acc);
#pragma unroll
                    for (int r = 0; r < 16; ++r) sc[r] += w[h] * fmaxf(acc[r], 0.f);
                }
#pragma unroll
                for (int q = 0; q < 4; ++q) { v2u o; o.x = __builtin_bit_cast(unsigned, __builtin_amdgcn_cvt_pkrtz(sc[4 * q], sc[4 * q + 1])); o.y = __builtin_bit_cast(unsigned, __builtin_amdgcn_cvt_pkrtz(sc[4 * q + 2], sc[4 * q + 3]));
                    *(GAS v2u*)(srow + 32 * kt + 8 * q + 4 * hi) = o; }
            }
        }
    }
}

template <int NI> __device__ __forceinline__ void select_row(Frame& F, int b, int t) {
    const unsigned short* srow = (const unsigned short*)(F.ws + WS_SC) + sc_row_off(b, t);
    unsigned char* mrow = (unsigned char*)(F.ws + WS_MSK) + (size_t)(b * SEQL + t) * 1024;
    const int lane = lane_now();
    unsigned k[NI * 8];
#pragma unroll
    for (int i = 0; i < NI; ++i) { const int s0 = 8 * (64 * i + lane), rem = t - s0;
        v4u raw = (v4u){0u, 0u, 0u, 0u};
        if (rem >= 0) raw = *(const GAS v4u*)(srow + s0);
#pragma unroll
        for (int e = 0; e < 8; ++e) { const unsigned wv = (e < 2) ? raw.x : (e < 4) ? raw.y : (e < 6) ? raw.z : raw.w; const unsigned hb = (e & 1) ? (wv >> 16) : (wv & 0xffffu);
            const unsigned key = (hb & 0x8000u) ? (~hb & 0xffffu) : (hb | 0x8000u); k[8 * i + e] = (e <= rem) ? key : 0u; } }
    unsigned T = 1u; bool fast = true;
    if (t + 1 > 256) {
        T = 0u;
#pragma unroll 1
        for (int bit = 15; bit >= 0; --bit) { const unsigned cand = T | (1u << bit); int cnt = 0;
#pragma unroll
            for (int j = 0; j < NI * 8; ++j) cnt += (k[j] >= cand) ? 1 : 0;
            cnt = wave_sum_i(cnt);
            if (cnt >= 256) T = cand; }
        int cge = 0, cgt = 0;
#pragma unroll
        for (int j = 0; j < NI * 8; ++j) { cge += (k[j] >= T) ? 1 : 0; cgt += (k[j] > T) ? 1 : 0; }
        cge = wave_sum_i(cge); cgt = wave_sum_i(cgt);
        const int need = 256 - cgt, neq = cge - cgt;
        if (neq != need) {
            fast = false; int base = 0;
#pragma unroll
            for (int i = 0; i < NI; ++i) { int below = 0, tot = 0;
#pragma unroll
                for (int e = 0; e < 8; ++e) { const unsigned long long em = __ballot(k[8 * i + e] == T);
                    below += (int)__builtin_amdgcn_mbcnt_hi((unsigned)(em >> 32), __builtin_amdgcn_mbcnt_lo((unsigned)em, 0u)); tot += __popcll(em); }
                int rank = base + below; unsigned byte = 0u;
#pragma unroll
                for (int e = 0; e < 8; ++e) { const unsigned kv = k[8 * i + e]; bool sel = kv > T; if (kv == T) { sel = rank < need; ++rank; } byte |= sel ? (1u << e) : 0u; }
                mrow[64 * i + lane] = (unsigned char)byte;
                base += tot; }
        }
    }
    if (fast) {
#pragma unroll
        for (int i = 0; i < NI; ++i) { unsigned byte = 0u;
#pragma unroll
            for (int e = 0; e < 8; ++e) byte |= (k[8 * i + e] >= T) ? (1u << e) : 0u;
            mrow[64 * i + lane] = (unsigned char)byte; }
    }
}
__device__ __forceinline__ void ph_select(Frame& F) {
    const int gw = F.vcu * 8 + F.wave, NGW = F.G * 8;
#pragma unroll 1
    for (int R = gw; R < NTOK; R += NGW) { const int b = R >> 13, t = R & 8191;
        if (t < 1024) select_row<2>(F, b, t); else if (t < 2048) select_row<4>(F, b, t); else if (t < 4096) select_row<8>(F, b, t); else select_row<16>(F, b, t); }
}

__device__ __forceinline__ void ph_swa(Frame& F, int l) {
    const bf16* P = (const bf16*)(F.ws + WS_P); const bf16* CVT = (const bf16*)(F.ws + WS_CVT); bf16* YC = (bf16*)(F.ws + WS_YC);
    const LAS float* TABC = (const LAS float*)(F.lds + LP_TABC); const LAS float* SINK = (const LAS float*)(F.lds + LP_SINK);
    const int r32 = F.lane & 31, hi = F.lane >> 5; const int gw = F.vcu * 8 + F.wave, NGW = F.G * 8;
#pragma unroll 1
    for (int id = gw; id < 4096; id += NGW) {
        const int b = id >> 11, hq = (id >> 8) & 7, g = id & 255, kvh = hq >> 2, t0 = 32 * g;
        const bf16* qrow = P + (size_t)(b * SEQL + t0 + r32) * PP + PC_CQ + hq * 64 + hi * 8;
        bf16x8 qf[4];
#pragma unroll
        for (int ks = 0; ks < 4; ++ks) qf[ks] = *(const GAS bf16x8*)(qrow + ks * 16);
        const float sink2 = SINK[l * 8 + hq];
        f32x16 p[5]; float mx = sink2;
#pragma unroll
        for (int jt = 0; jt < 5; ++jt) { const int kt = g - 4 + jt;
#pragma unroll
            for (int r = 0; r < 16; ++r) p[jt][r] = -INFINITY;
            if (kt >= 0) {
                const bf16* krow = P + (size_t)(b * SEQL + 32 * kt + r32) * PP + PC_CK + kvh * 64 + hi * 8;
                f32x16 acc;
#pragma unroll
                for (int r = 0; r < 16; ++r) acc[r] = 0.f;
#pragma unroll
                for (int ks = 0; ks < 4; ++ks) acc = MFMA32(*(const GAS bf16x8*)(krow + ks * 16), qf[ks], acc);
#pragma unroll
                for (int r = 0; r < 16; ++r) { const int d = 32 * (4 - jt) + r32 - crow16(r, hi); const bool ok = (d >= 0) && (d < 128); const int dc = ok ? d : 0;
                    const float x = acc[r] + TABC[hq * 128 + dc]; p[jt][r] = ok ? x : -INFINITY; mx = fmaxf(mx, p[jt][r]); }
            } }
        mx = xhalf_max(mx);
        float ls = 0.f;
#pragma unroll
        for (int jt = 0; jt < 5; ++jt)
#pragma unroll
            for (int r = 0; r < 16; ++r) { p[jt][r] = __builtin_amdgcn_exp2f(p[jt][r] - mx); ls += p[jt][r]; }
        ls = xhalf_sum(ls) + __builtin_amdgcn_exp2f(sink2 - mx);
        f32x16 o[2];
#pragma unroll
        for (int r = 0; r < 16; ++r) { o[0][r] = 0.f; o[1][r] = 0.f; }
#pragma unroll
        for (int jt = 0; jt < 5; ++jt) { const int kt = g - 4 + jt;
            if (kt >= 0) {
#pragma unroll
                for (int s2 = 0; s2 < 2; ++s2) {
                    v4u pw; pw.x = pk2(p[jt][8 * s2 + 0], p[jt][8 * s2 + 1]); pw.y = pk2(p[jt][8 * s2 + 2], p[jt][8 * s2 + 3]); pw.z = pk2(p[jt][8 * s2 + 4], p[jt][8 * s2 + 5]); pw.w = pk2(p[jt][8 * s2 + 6], p[jt][8 * s2 + 7]);
                    const bf16x8 pf = __builtin_bit_cast(bf16x8, pw);
#pragma unroll
                    for (int dt = 0; dt < 2; ++dt) { const bf16* vp = CVT + ((size_t)(b * 128 + kvh * 64 + 32 * dt + r32)) * 8192 + 32 * kt + 16 * s2 + 4 * hi;
                        const bf16x8 vf = cat44(*(const GAS s16x4*)vp, *(const GAS s16x4*)(vp + 8)); o[dt] = MFMA32(vf, pf, o[dt]); }
                } } }
        const float rl = 1.0f / ls; bf16* orow = YC + (size_t)(b * SEQL + t0 + r32) * 512 + hq * 64;
#pragma unroll
        for (int dt = 0; dt < 2; ++dt)
#pragma unroll
            for (int q = 0; q < 4; ++q) { v2u w; w.x = pk2(o[dt][4 * q] * rl, o[dt][4 * q + 1] * rl); w.y = pk2(o[dt][4 * q + 2] * rl, o[dt][4 * q + 3] * rl);
                *(GAS v2u*)(orow + 32 * dt + 8 * q + 4 * hi) = w; }
    }
}

__device__ __forceinline__ void ph_xattn(Frame& F, int l) {
    const bf16* XQ = (const bf16*)(F.ws + WS_XQ); const bf16* XK = (const bf16*)(F.ws + WS_XK) + (size_t)l * 512 * 1024; const bf16* XVT = (const bf16*)(F.ws + WS_XVT) + (size_t)l * 1024 * 512;
    bf16* XO = (bf16*)(F.ws + WS_XO); LAS bf16* KL = (LAS bf16*)F.lds;
    const int r32 = F.lane & 31, hi = F.lane >> 5;
#pragma unroll 1
    for (int base = F.vcu * 8; base < 2048; base += F.G * 8) {
        const int id = base + F.wave, b = id >> 10, h = (id >> 8) & 3, g = id & 255, t0 = 32 * g;
        __syncthreads();
#pragma unroll 4
        for (int c = F.tid; c < 8192; c += 512) { const int row = c >> 5, cc = c & 31;
            *(LAS v4u*)(KL + row * 264 + cc * 8) = *(const GAS v4u*)(XK + (size_t)(b * 256 + row) * 1024 + h * 256 + cc * 8); }
        f32x16 p[8];
#pragma unroll
        for (int kt = 0; kt < 8; ++kt)
#pragma unroll
            for (int r = 0; r < 16; ++r) p[kt][r] = 0.f;
        const bf16* qrow = XQ + (size_t)(b * SEQL + t0 + r32) * 1024 + h * 256 + hi * 8;
        bf16x8 qf[16];
#pragma unroll
        for (int ks = 0; ks < 16; ++ks) qf[ks] = *(const GAS bf16x8*)(qrow + ks * 16);
        __syncthreads();
#pragma unroll
        for (int ks = 0; ks < 16; ++ks)
#pragma unroll
            for (int kt = 0; kt < 8; ++kt) p[kt] = MFMA32(*(const LAS bf16x8*)(KL + (32 * kt + r32) * 264 + ks * 16 + hi * 8), qf[ks], p[kt]);
        float mx = -INFINITY;
#pragma unroll
        for (int kt = 0; kt < 8; ++kt)
#pragma unroll
            for (int r = 0; r < 16; ++r) mx = fmaxf(mx, p[kt][r]);
        mx = xhalf_max(mx);
        float ls = 0.f; v4u pw[8][2];
#pragma unroll
        for (int kt = 0; kt < 8; ++kt) {
#pragma unroll
            for (int r = 0; r < 16; ++r) { p[kt][r] = __builtin_amdgcn_exp2f(p[kt][r] - mx); ls += p[kt][r]; }
#pragma unroll
            for (int s2 = 0; s2 < 2; ++s2) { pw[kt][s2].x = pk2(p[kt][8 * s2 + 0], p[kt][8 * s2 + 1]); pw[kt][s2].y = pk2(p[kt][8 * s2 + 2], p[kt][8 * s2 + 3]); pw[kt][s2].z = pk2(p[kt][8 * s2 + 4], p[kt][8 * s2 + 5]); pw[kt][s2].w = pk2(p[kt][8 * s2 + 6], p[kt][8 * s2 + 7]); } }
        ls = xhalf_sum(ls); const float rl = 1.0f / ls;
        __syncthreads();
#pragma unroll 4
        for (int c = F.tid; c < 8192; c += 512) { const int row = c >> 5, cc = c & 31;
            const v4u v = *(const GAS v4u*)(XVT + (size_t)(h * 256 + row) * 512 + b * 256 + cc * 8);
            LAS bf16* d0 = KL + row * 264 + (cc >> 1) * 16 + (cc & 1) * 4;
            *(LAS v2u*)d0 = (v2u){v.x, v.y}; *(LAS v2u*)(d0 + 8) = (v2u){v.z, v.w}; }
        __syncthreads();
        bf16* orow = XO + (size_t)(b * SEQL + t0 + r32) * 1024 + h * 256;
#pragma unroll 1
        for (int dt = 0; dt < 8; ++dt) {
            f32x16 o;
#pragma unroll
            for (int r = 0; r < 16; ++r) o[r] = 0.f;
            const LAS bf16* vrow = KL + (32 * dt + r32) * 264 + 8 * hi;
#pragma unroll
            for (int kt = 0; kt < 8; ++kt)
#pragma unroll
                for (int s2 = 0; s2 < 2; ++s2) o = MFMA32(*(const LAS bf16x8*)(vrow + 32 * kt + 16 * s2), __builtin_bit_cast(bf16x8, pw[kt][s2]), o);
#pragma unroll
            for (int q = 0; q < 4; ++q) { v2u w; w.x = pk2(o[4 * q] * rl, o[4 * q + 1] * rl); w.y = pk2(o[4 * q + 2] * rl, o[4 * q + 3] * rl); *(GAS v2u*)(orow + 32 * dt + 8 * q + 4 * hi) = w; }
        }
    }
}

constexpr int HQ_QT = 0, HQ_KT = 8704, HQ_KHT = 17408, HQ_VT = 27648, HQ_DEC = 37888, HQ_GT = 38400, HQ_OST = 40448;
template <bool OUT> __device__ __forceinline__ void hgrn_item(Frame& F, int l, int item) {
    const int sc = item & 31, bh = item >> 5, b = bh >> 2, h = bh & 3;
    const bf16* P = (const bf16*)(F.ws + WS_P); const float* LOGF = (const float*)(F.ws + WS_LOGF);
    LAS bf16* QT = (LAS bf16*)(F.lds + HQ_QT); LAS bf16* KT = (LAS bf16*)(F.lds + HQ_KT); LAS bf16* KHT = (LAS bf16*)(F.lds + HQ_KHT); LAS bf16* VT = (LAS bf16*)(F.lds + HQ_VT);
    LAS float* DEC = (LAS float*)(F.lds + HQ_DEC); LAS float* GT = (LAS float*)(F.lds + HQ_GT); LAS float* OST = (LAS float*)(F.lds + HQ_OST);
    const int d = F.tid & 127, sg = F.tid >> 7, r32 = F.lane & 31, hi = F.lane >> 5, dvt = F.wave & 3, half = F.wave >> 2;
    f32x16 S[2];
#pragma unroll
    for (int i = 0; i < 2; ++i)
#pragma unroll
        for (int r = 0; r < 16; ++r) S[i][r] = 0.f;
    if (OUT && sc > 0) { const float* HS = (const float*)(F.ws + WS_HGS) + (size_t)item * 16384;
#pragma unroll
        for (int i = 0; i < 2; ++i)
#pragma unroll
            for (int r = 0; r < 16; ++r) S[i][r] = HS[(32 * (2 * half + i) + crow16(r, hi)) * 128 + 32 * dvt + r32]; }
    float atot = 0.f;
#pragma unroll 1
    for (int c = 0; c < 8; ++c) {
        const size_t tok0 = (size_t)b * SEQL + sc * 256 + c * 32;
        float lf[8], a[8], qs[8]; unsigned short vv[8];
#pragma unroll
        for (int i = 0; i < 8; ++i) { const size_t tk = tok0 + 8 * sg + i; lf[i] = LOGF[tk * 512 + h * 128 + d]; vv[i] = P[tk * PP + PC_BI + h * 128 + d]; if (OUT) qs[i] = bf2f(P[tk * PP + PC_BQ + h * 128 + d]); }
        a[0] = lf[0];
#pragma unroll
        for (int i = 1; i < 8; ++i) a[i] = a[i - 1] + lf[i];
        GT[sg * 128 + d] = a[7];
        __syncthreads();
        float off = 0.f, alast = 0.f;
#pragma unroll
        for (int g = 0; g < 4; ++g) { const float gt = GT[g * 128 + d]; off += (g < sg) ? gt : 0.f; alast += gt; }
        unsigned short khv[8];
#pragma unroll
        for (int i = 0; i < 8; ++i) { const float ai = off + a[i]; const float kk = -expm1f(lf[i]);
            if (OUT) { QT[(8 * sg + i) * 136 + d] = (bf16)f2bf(qs[i] * __expf(ai)); KT[(8 * sg + i) * 136 + d] = (bf16)f2bf(kk * __expf(-ai)); }
            khv[i] = (unsigned short)f2bf(kk * __expf(alast - ai)); }
        { v4u w; w.x = khv[0] | ((unsigned)khv[1] << 16); w.y = khv[2] | ((unsigned)khv[3] << 16); w.z = khv[4] | ((unsigned)khv[5] << 16); w.w = khv[6] | ((unsigned)khv[7] << 16); *(LAS v4u*)(KHT + d * 40 + 8 * sg) = w;
          v4u x; x.x = vv[0] | ((unsigned)vv[1] << 16); x.y = vv[2] | ((unsigned)vv[3] << 16); x.z = vv[4] | ((unsigned)vv[5] << 16); x.w = vv[6] | ((unsigned)vv[7] << 16); *(LAS v4u*)(VT + d * 40 + 8 * sg) = x; }
        if (sg == 0) { DEC[d] = __expf(alast); atot += alast; }
        __syncthreads();
        if (OUT) {
            f32x16 X;
#pragma unroll
            for (int r = 0; r < 16; ++r) X[r] = 0.f;
#pragma unroll
            for (int ks = 0; ks < 8; ++ks) X = MFMA32(*(const LAS bf16x8*)(KT + r32 * 136 + ks * 16 + hi * 8), *(const LAS bf16x8*)(QT + r32 * 136 + ks * 16 + hi * 8), X);
#pragma unroll
            for (int r = 0; r < 16; ++r) X[r] = (crow16(r, hi) <= r32) ? X[r] : 0.f;
            v4u xa;
            if (half == 0) { xa.x = pk2(X[0], X[1]); xa.y = pk2(X[2], X[3]); xa.z = pk2(X[4], X[5]); xa.w = pk2(X[6], X[7]); }
            else { xa.x = pk2(X[8], X[9]); xa.y = pk2(X[10], X[11]); xa.z = pk2(X[12], X[13]); xa.w = pk2(X[14], X[15]); }
            f32x16 Z;
#pragma unroll
            for (int r = 0; r < 16; ++r) Z[r] = 0.f;
            { const LAS bf16* vp = VT + (32 * dvt + r32) * 40 + 16 * half + 4 * hi; Z = MFMA32(__builtin_bit_cast(bf16x8, xa), cat44(*(const LAS s16x4*)vp, *(const LAS s16x4*)(vp + 8)), Z); }
#pragma unroll
            for (int i = 0; i < 2; ++i)
#pragma unroll
                for (int s2 = 0; s2 < 2; ++s2) { v4u sb; sb.x = pk2(S[i][8 * s2 + 0], S[i][8 * s2 + 1]); sb.y = pk2(S[i][8 * s2 + 2], S[i][8 * s2 + 3]); sb.z = pk2(S[i][8 * s2 + 4], S[i][8 * s2 + 5]); sb.w = pk2(S[i][8 * s2 + 6], S[i][8 * s2 + 7]);
                    const LAS bf16* qp = QT + r32 * 136 + 32 * (2 * half + i) + 16 * s2 + 4 * hi; Z = MFMA32(cat44(*(const LAS s16x4*)qp, *(const LAS s16x4*)(qp + 8)), __builtin_bit_cast(bf16x8, sb), Z); }
#pragma unroll
            for (int r = 0; r < 16; ++r) OST[(half * 32 + crow16(r, hi)) * 132 + 32 * dvt + r32] = Z[r];
        }
#pragma unroll
        for (int i = 0; i < 2; ++i) { const int dkt = 2 * half + i;
#pragma unroll
            for (int r = 0; r < 16; ++r) S[i][r] *= DEC[32 * dkt + crow16(r, hi)];
#pragma unroll
            for (int ks = 0; ks < 2; ++ks) S[i] = MFMA32(*(const LAS bf16x8*)(KHT + (32 * dkt + r32) * 40 + 16 * ks + 8 * hi), *(const LAS bf16x8*)(VT + (32 * dvt + r32) * 40 + 16 * ks + 8 * hi), S[i]); }
        if (OUT) {
            __syncthreads();
            const int t = F.tid >> 4, part = F.tid & 15; float o[8]; float ss = 0.f;
#pragma unroll
            for (int j = 0; j < 8; ++j) { o[j] = OST[t * 132 + 8 * part + j] + OST[(32 + t) * 132 + 8 * part + j]; ss += o[j] * o[j]; }
            ss = dpp_row_sum_f(ss);
            const float rinv = 1.0f / sqrtf(ss * (1.0f / 128.0f) + RMS_EPS_);
            const v4u gg = *(const GAS v4u*)(P + (tok0 + t) * PP + PC_BG + h * 128 + 8 * part);
            const float* ng = F.in[I_NG] + (size_t)l * 512 + h * 128 + 8 * part;
            v4u w; w.x = pk2(o[0] * rinv * ng[0] * bflo(gg.x), o[1] * rinv * ng[1] * bfhi(gg.x)); w.y = pk2(o[2] * rinv * ng[2] * bflo(gg.y), o[3] * rinv * ng[3] * bfhi(gg.y));
            w.z = pk2(o[4] * rinv * ng[4] * bflo(gg.z), o[5] * rinv * ng[5] * bfhi(gg.z)); w.w = pk2(o[6] * rinv * ng[6] * bflo(gg.w), o[7] * rinv * ng[7] * bfhi(gg.w));
            *(GAS v4u*)((bf16*)(F.ws + WS_YB) + (tok0 + t) * 512 + h * 128 + 8 * part) = w;
        }
        __syncthreads();
    }
    if (!OUT) { float* HL = (float*)(F.ws + WS_HGL) + (size_t)item * 16384;
#pragma unroll
        for (int i = 0; i < 2; ++i)
#pragma unroll
            for (int r = 0; r < 16; ++r) HL[(32 * (2 * half + i) + crow16(r, hi)) * 128 + 32 * dvt + r32] = S[i][r];
        if (sg == 0) ((float*)(F.ws + WS_HGD))[item * 128 + d] = __expf(atot); }
}
__device__ __forceinline__ void ph_hgrn_scan(Frame& F) {
    const float* HL = (const float*)(F.ws + WS_HGL); const float* HD = (const float*)(F.ws + WS_HGD); float* HS = (float*)(F.ws + WS_HGS);
    for (int e = F.vcu * 512 + F.tid; e < 8 * 16384; e += F.G * 512) { const int bh = e >> 14, el = e & 16383, dk = el >> 7; float s = 0.f;
#pragma unroll 4
        for (int sc = 0; sc < 32; ++sc) { const int item = bh * 32 + sc; HS[(size_t)item * 16384 + el] = s; s = HD[item * 128 + dk] * s + HL[(size_t)item * 16384 + el]; } }
}
struct Args { const float* in[21]; float* out; unsigned char* ws; int ph_lo, ph_hi; };
constexpr int PH_PER_LAYER = 15, PH_TOTAL = 1 + 2 * PH_PER_LAYER;

__device__ __forceinline__ int t5_bucket_dev(int d) {
    if (d < 16) return d;
    int v = 16 + (int)(logf((float)d / 16.0f) / 2.0794415416798357f * 16.0f);
    return v < 31 ? v : 31;
}

__global__ void __launch_bounds__(512, 2) mk_fwd(Args args) {
    extern __shared__ __attribute__((aligned(16))) unsigned char lds[];
    Frame F;
    F.lds = (LAS unsigned char*)lds; F.ws = args.ws; F.ctl = (gu32*)(args.ws + WS_CTL);
    F.tid = threadIdx.x; F.lane = F.tid & 63; F.wave = __builtin_amdgcn_readfirstlane(F.tid >> 6); F.wave0 = F.wave;
    F.G = gridDim.x; { const int bx = blockIdx.x; F.vcu = (F.G % 8 == 0) ? (bx % 8) * (F.G / 8) + bx / 8 : bx; }
    for (int i = F.tid; i < LDS_BYTES / 16; i += 512) ((LAS v4u*)F.lds)[i] = (v4u){0u, 0u, 0u, 0u};
    __syncthreads();
    { LAS unsigned long long* PT = (LAS unsigned long long*)(F.lds + LP_PTRS);
#pragma unroll
      for (int i = 0; i < 21; ++i) if (F.tid == i) PT[i] = (unsigned long long)args.in[i];
      F.in.p = (const LAS unsigned*)(F.lds + LP_PTRS); }
    F.out = args.out;
    __syncthreads();
    volatile LAS unsigned* MISC = (volatile LAS unsigned*)(F.lds + LP_MISC);
    if (F.tid < 64) MISC[F.tid] = 0u;
    { LAS float* TABA = (LAS float*)(F.lds + LP_TABA); LAS float* TABC = (LAS float*)(F.lds + LP_TABC); LAS float* CBA = (LAS float*)(F.lds + LP_CBA); LAS float* SINK = (LAS float*)(F.lds + LP_SINK);
      const float* rb = F.in[I_RELB];
      for (int i = F.tid; i < 8 * 132; i += 512) { const int h = i / 132, d = i % 132; TABA[i] = (d < 128) ? (rb[t5_bucket_dev(d) * 16 + h] - rb[31 * 16 + h]) * LOG2E : 0.f; }
      for (int i = F.tid; i < 8 * 128; i += 512) { const int h = i >> 7, d = i & 127; TABC[i] = rb[t5_bucket_dev(d) * 16 + 8 + h] * LOG2E; }
      if (F.tid < 8) CBA[F.tid] = rb[31 * 16 + F.tid] * LOG2E;
      if (F.tid < 16) SINK[F.tid] = F.in[I_SINK][F.tid] * LOG2E; }
    __syncthreads();
    XcdBarrier bar = xcd_barrier_post((unsigned*)(F.ctl + CW_BAR), MISC + 8);
    const int lo = args.ph_lo, hi = args.ph_hi;
#ifndef PHMASK
#define PHMASK 0xFFFFu
#endif
#define IN(k) (lo <= (k) && (k) < hi)
#define INL(j) (((PHMASK >> (1 + (j))) & 1u) && lo <= (pb + (j)) && (pb + (j)) < hi)
#define SEAM(k) do { if (IN(k) && IN((k) + 1)) { PHASE_ENTER(F); xcd_barrier(bar, F.tid == 0); } } while (0)
    LAS unsigned char* RING = F.lds;

    if ((PHMASK & 1u) && IN(0)) { PHASE_ENTER(F); ph_prologue(F); } SEAM(0);

#pragma unroll 1
    for (int l = 0; l < NLAYER; ++l) {
        const int pb = 1 + PH_PER_LAYER * l;
#define HB ((const bf16*)(F.ws + WS_HB))
#define WIN ((const bf16*)(F.ws + WS_WIN) + (size_t)l * 8192 * 1024)
#define Hres ((l == 0) ? F.in[I_X] : (const float*)F.out)
        if (INL(0)) { PHASE_ENTER(F);
            { pg8::Gemm g{HB, WIN, NTOK, PP, 1024}; pg8::StaticOrder S; S.init(NTOK, PP, F.G, (int)blockIdx.x);
              pg8::EpiProj E{(bf16*)(F.ws + WS_P), (float*)(F.ws + WS_LOGF), (bf16*)(F.ws + WS_CVT), (const float*)(F.ws + WS_MISC + MISC_LB) + l * 512};
              pg8::gemm_phase<pg8::EpiProj, pg8::StaticOrder, true, true>(RING, F.wave, g, S, E);
#if defined(DUP) && DUP == 6
              __syncthreads(); PHASE_ENTER(F); pg8::gemm_phase<pg8::EpiProj, pg8::StaticOrder, true, true>(RING, F.wave, g, S, E);
#endif
            }
            if (l == 0) {
#pragma unroll 1
                for (int q = 0; q < 4; ++q) { const int ll = q >> 1, isv = q & 1;
                    const bf16* MEMB = (const bf16*)(F.ws + WS_MEMB); const bf16* WKV = (const bf16*)(F.ws + WS_XWKV) + (size_t)ll * 2048 * 1024;
                    pg8::Gemm g = isv ? pg8::Gemm{WKV + (size_t)1024 * 1024, MEMB, 1024, 512, 1024} : pg8::Gemm{MEMB, WKV, 512, 1024, 1024};
                    pg8::StaticOrder S; S.init(g.M, g.N, F.G, (int)blockIdx.x);
                    pg8::EpiStore<0> E{isv ? (bf16*)(F.ws + WS_XVT) + (size_t)ll * 1024 * 512 : (bf16*)(F.ws + WS_XK) + (size_t)ll * 512 * 1024, isv ? 512 : 1024, 1.0f};
                    __syncthreads();
                    pg8::gemm_phase<pg8::EpiStore<0>, pg8::StaticOrder, true, true>(RING, F.wave, g, S, E); }
            }
        }
        SEAM(pb + 0);
        if (INL(1)) { PHASE_ENTER(F);
#ifndef SUBM
#define SUBM 7
#endif
            if (SUBM & 1) for (int it = F.vcu; it < 256; it += F.G) hgrn_item<false>(F, l, it);
#if defined(DUP) && DUP == 4
            __syncthreads(); PHASE_ENTER(F); for (int it = F.vcu; it < 256; it += F.G) hgrn_item<false>(F, l, it);
#endif
            PHASE_ENTER(F);
            if (SUBM & 2) ph_indexer(F);
#if defined(DUP) && DUP == 1
            PHASE_ENTER(F); ph_indexer(F);
#endif
            PHASE_ENTER(F);
            if (SUBM & 4) ph_swa(F, l);
#if defined(DUP) && DUP == 10
            PHASE_ENTER(F); ph_swa(F, l);
#endif
        }
        SEAM(pb + 1);
        if (INL(2)) { PHASE_ENTER(F); if (SUBM & 1) ph_select(F); PHASE_ENTER(F);
#if defined(DUP) && DUP == 2
            ph_select(F); PHASE_ENTER(F);
#endif
            if (SUBM & 2) ph_hgrn_scan(F); }
        SEAM(pb + 2);
        if (INL(3)) { PHASE_ENTER(F);
            if (SUBM & 1) { const attn_body::AttnTensors AT{(const attn_body::bf16*)(F.ws + WS_P) + PC_AQ, (const attn_body::bf16*)(F.ws + WS_P) + PC_AK, (const attn_body::bf16*)(F.ws + WS_P) + PC_AV, (attn_body::bf16*)(F.ws + WS_YA), (const unsigned char*)(F.ws + WS_MSK)};
              const attn_body::StaticOrder S((int)F.G, (int)blockIdx.x);
              attn_body::attn_phase<attn_body::StaticOrder>((char*)lds, F.wave, AT, S, (const LAS float*)(F.lds + LP_TABA), (const LAS float*)(F.lds + LP_CBA)); }
#if defined(DUP) && DUP == 3
            __syncthreads(); PHASE_ENTER(F);
            if (SUBM & 1) { const attn_body::AttnTensors AT{(const attn_body::bf16*)(F.ws + WS_P) + PC_AQ, (const attn_body::bf16*)(F.ws + WS_P) + PC_AK, (const attn_body::bf16*)(F.ws + WS_P) + PC_AV, (attn_body::bf16*)(F.ws + WS_YA), (const unsigned char*)(F.ws + WS_MSK)};
              const attn_body::StaticOrder S((int)F.G, (int)blockIdx.x);
              attn_body::attn_phase<attn_body::StaticOrder>((char*)lds, F.wave, AT, S, (const LAS float*)(F.lds + LP_TABA), (const LAS float*)(F.lds + LP_CBA)); }
#endif
            __syncthreads(); PHASE_ENTER(F);
            if (SUBM & 2) for (int it = F.vcu; it < 256; it += F.G) hgrn_item<true>(F, l, it);
#if defined(DUP) && DUP == 4
            __syncthreads(); PHASE_ENTER(F); for (int it = F.vcu; it < 256; it += F.G) hgrn_item<true>(F, l, it);
#endif
            __syncthreads(); PHASE_ENTER(F);
            if (SUBM & 4) { pg8::Gemm g{HB, WIN + (size_t)PP * 1024, NTOK, 3072, 1024}; pg8::StaticOrder S; S.init(NTOK, 3072, F.G, (int)blockIdx.x);
              pg8::EpiStore<1> E{(bf16*)(F.ws + WS_GATE), 3072, 1.0f};
              pg8::gemm_phase<pg8::EpiStore<1>, pg8::StaticOrder, true, true>(RING, F.wave, g, S, E); }
        }
        SEAM(pb + 3);
        if (INL(4)) { PHASE_ENTER(F);
#pragma unroll 1
            for (int g3 = 0; g3 < 3; ++g3) {
                pg8::Gemm g{(const bf16*)(F.ws + WS_YA) + (size_t)g3 * NTOK * 512, (const bf16*)(F.ws + WS_WBR) + (size_t)(l * 3 + g3) * 1024 * 512, NTOK, 1024, 512}; pg8::StaticOrder S; S.init(NTOK, 1024, F.G, (int)blockIdx.x);
                pg8::EpiMerge E{(const bf16*)(F.ws + WS_GATE), (float*)(F.ws + WS_MRG), (bf16*)(F.ws + WS_MERGED), g3};
                __syncthreads();
                pg8::gemm_phase<pg8::EpiMerge, pg8::StaticOrder, false, true>(RING, F.wave, g, S, E); }
        }
        SEAM(pb + 4);
        if (INL(5)) { PHASE_ENTER(F);
            pg8::Gemm g{(const bf16*)(F.ws + WS_MERGED), (const bf16*)(F.ws + WS_WOUT) + (size_t)l * 1024 * 1024, NTOK, 1024, 1024}; pg8::StaticOrder S; S.init(NTOK, 1024, F.G, (int)blockIdx.x);
            pg8::EpiResid E{Hres, (float*)(F.ws + WS_T), DN_ALPHA};
            pg8::gemm_phase<pg8::EpiResid, pg8::StaticOrder, false, true>(RING, F.wave, g, S, E);
        }
        SEAM(pb + 5);
        if (INL(6)) { PHASE_ENTER(F); ph_ln<0>(F, l, 0, nullptr); __syncthreads();
#if defined(DUP) && DUP == 5
            PHASE_ENTER(F); ph_ln<0>(F, l, 0, nullptr); __syncthreads(); PHASE_ENTER(F); ph_ln<0>(F, l, 0, nullptr); __syncthreads();
#endif
            PHASE_ENTER(F); ph_moe_convert(F, l);
#if defined(DUP) && DUP == 8
            __syncthreads(); PHASE_ENTER(F); ph_moe_convert(F, l);
#endif
        }
        SEAM(pb + 6);
        if (INL(7)) { PHASE_ENTER(F);
            pg8::Gemm g{HB, (const bf16*)(F.ws + WS_XWQ) + (size_t)l * 1024 * 1024, NTOK, 1024, 1024}; pg8::StaticOrder S; S.init(NTOK, 1024, F.G, (int)blockIdx.x);
            pg8::EpiStore<0> E{(bf16*)(F.ws + WS_XQ), 1024, pg8::XQ_C2};
            pg8::gemm_phase<pg8::EpiStore<0>, pg8::StaticOrder, false, true>(RING, F.wave, g, S, E);
        }
        SEAM(pb + 7);
        if (INL(8)) { PHASE_ENTER(F); ph_xattn(F, l);
#if defined(DUP) && DUP == 9
            PHASE_ENTER(F); ph_xattn(F, l);
#endif
        }
        SEAM(pb + 8);
        if (INL(9)) { PHASE_ENTER(F);
            pg8::Gemm g{(const bf16*)(F.ws + WS_XO), (const bf16*)(F.ws + WS_XWO) + (size_t)l * 1024 * 1024, NTOK, 1024, 1024}; pg8::StaticOrder S; S.init(NTOK, 1024, F.G, (int)blockIdx.x);
            pg8::EpiResid E{F.out, (float*)(F.ws + WS_T), DN_ALPHA};
            pg8::gemm_phase<pg8::EpiResid, pg8::StaticOrder, false, true>(RING, F.wave, g, S, E);
        }
        SEAM(pb + 9);
        if (INL(10)) { PHASE_ENTER(F); ph_ln<1>(F, l, 1, nullptr); }
        SEAM(pb + 10);
        if (INL(11)) { PHASE_ENTER(F); ph_slots(F, l); }
        SEAM(pb + 11);
        if (INL(12)) { PHASE_ENTER(F);
            const int nblk = (int)__hip_atomic_load(F.ctl + CW_NBLK + l * 64, RLX_AGENT);
            pg8::Gemm g{(const bf16*)(F.ws + WS_XS), (const bf16*)(F.ws + WS_MW13), MOE_MAXSLOT, 32 * 1024, 1024};
            pg8::MoeOrder S{(const int*)(F.ws + WS_MISC + MISC_BLKE) + l * 256, nblk * 4, F.G, F.vcu};
            pg8::EpiMoeUp E{(bf16*)(F.ws + WS_HID)};
            pg8::gemm_phase<pg8::EpiMoeUp, pg8::MoeOrder, true, true>(RING, F.wave, g, S, E);
#if defined(DUP) && DUP == 7
            __syncthreads(); PHASE_ENTER(F); pg8::gemm_phase<pg8::EpiMoeUp, pg8::MoeOrder, true, true>(RING, F.wave, g, S, E);
#endif
        }
        SEAM(pb + 12);
        if (INL(13)) { PHASE_ENTER(F);
            const int nblk = (int)__hip_atomic_load(F.ctl + CW_NBLK + l * 64, RLX_AGENT);
            pg8::Gemm g{(const bf16*)(F.ws + WS_HID), (const bf16*)(F.ws + WS_MW2), MOE_MAXSLOT, 32 * 1024, 512};
            pg8::MoeOrder S{(const int*)(F.ws + WS_MISC + MISC_BLKE) + l * 256, nblk * 4, F.G, F.vcu};
            pg8::EpiMoeDown E{(bf16*)(F.ws + WS_YASG), (const int*)(F.ws + WS_FF) + l * MOE_MAXSLOT};
            pg8::gemm_phase<pg8::EpiMoeDown, pg8::MoeOrder, true, true>(RING, F.wave, g, S, E);
#if defined(DUP) && DUP == 7
            __syncthreads(); PHASE_ENTER(F); pg8::gemm_phase<pg8::EpiMoeDown, pg8::MoeOrder, true, true>(RING, F.wave, g, S, E);
#endif
        }
        SEAM(pb + 13);
        if (INL(14)) { PHASE_ENTER(F); ph_ln<2>(F, l, 2, F.out); }
        SEAM(pb + 14);
    }
#ifdef MK_TMOCHK
    { PHASE_ENTER(F); xcd_barrier(bar, F.tid == 0);
      const unsigned tmo = __hip_atomic_load(F.ctl + CW_BAR + XB_TMO, RLX_AGENT);
      if (tmo) { for (size_t i = (size_t)F.vcu * 512 + F.tid; i < (size_t)NTOK * DMOD; i += (size_t)F.G * 512) F.out[i] += 1.0f; } }
#endif
#undef IN
#undef SEAM
}

#ifdef MK_DBL
__global__ void __launch_bounds__(256) cs_kernel(const unsigned* ws, size_t nws, const unsigned* out, size_t nout, unsigned long long* slot) {
    unsigned long long s = 0; const size_t gt = (size_t)blockIdx.x * 256 + threadIdx.x, NT = (size_t)gridDim.x * 256;
    for (size_t i = gt; i < nws; i += NT) s += (unsigned long long)ws[i] * (2 * i + 1);
    for (size_t i = gt; i < nout; i += NT) s += (unsigned long long)out[i] * (2 * (i + nws) + 1);
    for (int o = 32; o > 0; o >>= 1) s += __shfl_xor(s, o);
    if ((threadIdx.x & 63) == 0) atomicAdd(slot, s);
}
__global__ void __launch_bounds__(512, 2) scrub_kernel(unsigned* sink) {
    extern __shared__ __attribute__((aligned(16))) unsigned char sl[];
    for (int i = threadIdx.x; i < 163840 / 4; i += 512) ((unsigned*)sl)[i] = 0x7fc0dead ^ (unsigned)i;
    __syncthreads();
    asm volatile("v_mov_b32 v0, 0x7fc12345\n\tv_mov_b32 v1, 0x7fc12345\n\tv_mov_b32 v2, 0x7fc12345\n\tv_mov_b32 v3, 0x7fc12345\n\tv_mov_b32 v4, 0x7fc12345\n\tv_mov_b32 v5, 0x7fc12345\n\tv_mov_b32 v6, 0x7fc12345\n\tv_mov_b32 v7, 0x7fc12345\n\tv_mov_b32 v8, 0x7fc12345\n\tv_mov_b32 v9, 0x7fc12345\n\tv_mov_b32 v10, 0x7fc12345\n\tv_mov_b32 v11, 0x7fc12345\n\tv_mov_b32 v12, 0x7fc12345\n\tv_mov_b32 v13, 0x7fc12345\n\tv_mov_b32 v14, 0x7fc12345\n\tv_mov_b32 v15, 0x7fc12345\n\tv_mov_b32 v16, 0x7fc12345\n\tv_mov_b32 v17, 0x7fc12345\n\tv_mov_b32 v18, 0x7fc12345\n\tv_mov_b32 v19, 0x7fc12345\n\tv_mov_b32 v20, 0x7fc12345\n\tv_mov_b32 v21, 0x7fc12345\n\tv_mov_b32 v22, 0x7fc12345\n\tv_mov_b32 v23, 0x7fc12345\n\tv_mov_b32 v24, 0x7fc12345\n\tv_mov_b32 v25, 0x7fc12345\n\tv_mov_b32 v26, 0x7fc12345\n\tv_mov_b32 v27, 0x7fc12345\n\tv_mov_b32 v28, 0x7fc12345\n\tv_mov_b32 v29, 0x7fc12345\n\tv_mov_b32 v30, 0x7fc12345\n\tv_mov_b32 v31, 0x7fc12345\n\tv_mov_b32 v32, 0x7fc12345\n\tv_mov_b32 v33, 0x7fc12345\n\tv_mov_b32 v34, 0x7fc12345\n\tv_mov_b32 v35, 0x7fc12345\n\tv_mov_b32 v36, 0x7fc12345\n\tv_mov_b32 v37, 0x7fc12345\n\tv_mov_b32 v38, 0x7fc12345\n\tv_mov_b32 v39, 0x7fc12345\n\tv_mov_b32 v40, 0x7fc12345\n\tv_mov_b32 v41, 0x7fc12345\n\tv_mov_b32 v42, 0x7fc12345\n\tv_mov_b32 v43, 0x7fc12345\n\tv_mov_b32 v44, 0x7fc12345\n\tv_mov_b32 v45, 0x7fc12345\n\tv_mov_b32 v46, 0x7fc12345\n\tv_mov_b32 v47, 0x7fc12345\n\tv_mov_b32 v48, 0x7fc12345\n\tv_mov_b32 v49, 0x7fc12345\n\tv_mov_b32 v50, 0x7fc12345\n\tv_mov_b32 v51, 0x7fc12345\n\tv_mov_b32 v52, 0x7fc12345\n\tv_mov_b32 v53, 0x7fc12345\n\tv_mov_b32 v54, 0x7fc12345\n\tv_mov_b32 v55, 0x7fc12345\n\tv_mov_b32 v56, 0x7fc12345\n\tv_mov_b32 v57, 0x7fc12345\n\tv_mov_b32 v58, 0x7fc12345\n\tv_mov_b32 v59, 0x7fc12345\n\tv_mov_b32 v60, 0x7fc12345\n\tv_mov_b32 v61, 0x7fc12345\n\tv_mov_b32 v62, 0x7fc12345\n\tv_mov_b32 v63, 0x7fc12345\n\tv_mov_b32 v64, 0x7fc12345\n\tv_mov_b32 v65, 0x7fc12345\n\tv_mov_b32 v66, 0x7fc12345\n\tv_mov_b32 v67, 0x7fc12345\n\tv_mov_b32 v68, 0x7fc12345\n\tv_mov_b32 v69, 0x7fc12345\n\tv_mov_b32 v70, 0x7fc12345\n\tv_mov_b32 v71, 0x7fc12345\n\tv_mov_b32 v72, 0x7fc12345\n\tv_mov_b32 v73, 0x7fc12345\n\tv_mov_b32 v74, 0x7fc12345\n\tv_mov_b32 v75, 0x7fc12345\n\tv_mov_b32 v76, 0x7fc12345\n\tv_mov_b32 v77, 0x7fc12345\n\tv_mov_b32 v78, 0x7fc12345\n\tv_mov_b32 v79, 0x7fc12345\n\tv_mov_b32 v80, 0x7fc12345\n\tv_mov_b32 v81, 0x7fc12345\n\tv_mov_b32 v82, 0x7fc12345\n\tv_mov_b32 v83, 0x7fc12345\n\tv_mov_b32 v84, 0x7fc12345\n\tv_mov_b32 v85, 0x7fc12345\n\tv_mov_b32 v86, 0x7fc12345\n\tv_mov_b32 v87, 0x7fc12345\n\tv_mov_b32 v88, 0x7fc12345\n\tv_mov_b32 v89, 0x7fc12345\n\tv_mov_b32 v90, 0x7fc12345\n\tv_mov_b32 v91, 0x7fc12345\n\tv_mov_b32 v92, 0x7fc12345\n\tv_mov_b32 v93, 0x7fc12345\n\tv_mov_b32 v94, 0x7fc12345\n\tv_mov_b32 v95, 0x7fc12345\n\tv_mov_b32 v96, 0x7fc12345\n\tv_mov_b32 v97, 0x7fc12345\n\tv_mov_b32 v98, 0x7fc12345\n\tv_mov_b32 v99, 0x7fc12345\n\tv_mov_b32 v100, 0x7fc12345\n\tv_mov_b32 v101, 0x7fc12345\n\tv_mov_b32 v102, 0x7fc12345\n\tv_mov_b32 v103, 0x7fc12345\n\tv_mov_b32 v104, 0x7fc12345\n\tv_mov_b32 v105, 0x7fc12345\n\tv_mov_b32 v106, 0x7fc12345\n\tv_mov_b32 v107, 0x7fc12345\n\tv_mov_b32 v108, 0x7fc12345\n\tv_mov_b32 v109, 0x7fc12345\n\tv_mov_b32 v110, 0x7fc12345\n\tv_mov_b32 v111, 0x7fc12345\n\tv_mov_b32 v112, 0x7fc12345\n\tv_mov_b32 v113, 0x7fc12345\n\tv_mov_b32 v114, 0x7fc12345\n\tv_mov_b32 v115, 0x7fc12345\n\tv_mov_b32 v116, 0x7fc12345\n\tv_mov_b32 v117, 0x7fc12345\n\tv_mov_b32 v118, 0x7fc12345\n\tv_mov_b32 v119, 0x7fc12345\n\tv_mov_b32 v120, 0x7fc12345\n\tv_mov_b32 v121, 0x7fc12345\n\tv_mov_b32 v122, 0x7fc12345\n\tv_mov_b32 v123, 0x7fc12345\n\tv_mov_b32 v124, 0x7fc12345\n\tv_mov_b32 v125, 0x7fc12345\n\tv_mov_b32 v126, 0x7fc12345\n\tv_mov_b32 v127, 0x7fc12345\n\tv_mov_b32 v128, 0x7fc12345\n\tv_mov_b32 v129, 0x7fc12345\n\tv_mov_b32 v130, 0x7fc12345\n\tv_mov_b32 v131, 0x7fc12345\n\tv_mov_b32 v132, 0x7fc12345\n\tv_mov_b32 v133, 0x7fc12345\n\tv_mov_b32 v134, 0x7fc12345\n\tv_mov_b32 v135, 0x7fc12345\n\tv_mov_b32 v136, 0x7fc12345\n\tv_mov_b32 v137, 0x7fc12345\n\tv_mov_b32 v138, 0x7fc12345\n\tv_mov_b32 v139, 0x7fc12345\n\tv_mov_b32 v140, 0x7fc12345\n\tv_mov_b32 v141, 0x7fc12345\n\tv_mov_b32 v142, 0x7fc12345\n\tv_mov_b32 v143, 0x7fc12345\n\tv_mov_b32 v144, 0x7fc12345\n\tv_mov_b32 v145, 0x7fc12345\n\tv_mov_b32 v146, 0x7fc12345\n\tv_mov_b32 v147, 0x7fc12345\n\tv_mov_b32 v148, 0x7fc12345\n\tv_mov_b32 v149, 0x7fc12345\n\tv_mov_b32 v150, 0x7fc12345\n\tv_mov_b32 v151, 0x7fc12345\n\tv_mov_b32 v152, 0x7fc12345\n\tv_mov_b32 v153, 0x7fc12345\n\tv_mov_b32 v154, 0x7fc12345\n\tv_mov_b32 v155, 0x7fc12345\n\tv_mov_b32 v156, 0x7fc12345\n\tv_mov_b32 v157, 0x7fc12345\n\tv_mov_b32 v158, 0x7fc12345\n\tv_mov_b32 v159, 0x7fc12345\n\tv_mov_b32 v160, 0x7fc12345\n\tv_mov_b32 v161, 0x7fc12345\n\tv_mov_b32 v162, 0x7fc12345\n\tv_mov_b32 v163, 0x7fc12345\n\tv_mov_b32 v164, 0x7fc12345\n\tv_mov_b32 v165, 0x7fc12345\n\tv_mov_b32 v166, 0x7fc12345\n\tv_mov_b32 v167, 0x7fc12345\n\tv_mov_b32 v168, 0x7fc12345\n\tv_mov_b32 v169, 0x7fc12345\n\tv_mov_b32 v170, 0x7fc12345\n\tv_mov_b32 v171, 0x7fc12345\n\tv_mov_b32 v172, 0x7fc12345\n\tv_mov_b32 v173, 0x7fc12345\n\tv_mov_b32 v174, 0x7fc12345\n\tv_mov_b32 v175, 0x7fc12345\n\tv_mov_b32 v176, 0x7fc12345\n\tv_mov_b32 v177, 0x7fc12345\n\tv_mov_b32 v178, 0x7fc12345\n\tv_mov_b32 v179, 0x7fc12345\n\tv_mov_b32 v180, 0x7fc12345\n\tv_mov_b32 v181, 0x7fc12345\n\tv_mov_b32 v182, 0x7fc12345\n\tv_mov_b32 v183, 0x7fc12345\n\tv_mov_b32 v184, 0x7fc12345\n\tv_mov_b32 v185, 0x7fc12345\n\tv_mov_b32 v186, 0x7fc12345\n\tv_mov_b32 v187, 0x7fc12345\n\tv_mov_b32 v188, 0x7fc12345\n\tv_mov_b32 v189, 0x7fc12345\n\tv_mov_b32 v190, 0x7fc12345\n\tv_mov_b32 v191, 0x7fc12345\n\tv_mov_b32 v192, 0x7fc12345\n\tv_mov_b32 v193, 0x7fc12345\n\tv_mov_b32 v194, 0x7fc12345\n\tv_mov_b32 v195, 0x7fc12345\n\tv_mov_b32 v196, 0x7fc12345\n\tv_mov_b32 v197, 0x7fc12345\n\tv_mov_b32 v198, 0x7fc12345\n\tv_mov_b32 v199, 0x7fc12345\n\tv_mov_b32 v200, 0x7fc12345\n\tv_mov_b32 v201, 0x7fc12345\n\tv_mov_b32 v202, 0x7fc12345\n\tv_mov_b32 v203, 0x7fc12345\n\tv_mov_b32 v204, 0x7fc12345\n\tv_mov_b32 v205, 0x7fc12345\n\tv_mov_b32 v206, 0x7fc12345\n\tv_mov_b32 v207, 0x7fc12345\n\tv_mov_b32 v208, 0x7fc12345\n\tv_mov_b32 v209, 0x7fc12345\n\tv_mov_b32 v210, 0x7fc12345\n\tv_mov_b32 v211, 0x7fc12345\n\tv_mov_b32 v212, 0x7fc12345\n\tv_mov_b32 v213, 0x7fc12345\n\tv_mov_b32 v214, 0x7fc12345\n\tv_mov_b32 v215, 0x7fc12345\n\tv_mov_b32 v216, 0x7fc12345\n\tv_mov_b32 v217, 0x7fc12345\n\tv_mov_b32 v218, 0x7fc12345\n\tv_mov_b32 v219, 0x7fc12345\n\tv_mov_b32 v220, 0x7fc12345\n\tv_mov_b32 v221, 0x7fc12345\n\tv_mov_b32 v222, 0x7fc12345\n\tv_mov_b32 v223, 0x7fc12345\n\tv_mov_b32 v224, 0x7fc12345\n\tv_mov_b32 v225, 0x7fc12345\n\tv_mov_b32 v226, 0x7fc12345\n\tv_mov_b32 v227, 0x7fc12345\n\tv_mov_b32 v228, 0x7fc12345\n\tv_mov_b32 v229, 0x7fc12345\n\tv_mov_b32 v230, 0x7fc12345\n\tv_mov_b32 v231, 0x7fc12345\n\tv_mov_b32 v232, 0x7fc12345\n\tv_mov_b32 v233, 0x7fc12345\n\tv_mov_b32 v234, 0x7fc12345\n\tv_mov_b32 v235, 0x7fc12345\n\tv_mov_b32 v236, 0x7fc12345\n\tv_mov_b32 v237, 0x7fc12345\n\tv_mov_b32 v238, 0x7fc12345\n\tv_mov_b32 v239, 0x7fc12345\n\tv_mov_b32 v240, 0x7fc12345\n\tv_mov_b32 v241, 0x7fc12345\n\tv_mov_b32 v242, 0x7fc12345\n\tv_mov_b32 v243, 0x7fc12345\n\tv_mov_b32 v244, 0x7fc12345\n\tv_mov_b32 v245, 0x7fc12345\n\tv_mov_b32 v246, 0x7fc12345\n\tv_mov_b32 v247, 0x7fc12345\n\tv_mov_b32 v248, 0x7fc12345\n\tv_mov_b32 v249, 0x7fc12345\n\tv_mov_b32 v250, 0x7fc12345\n\tv_mov_b32 v251, 0x7fc12345\n\tv_mov_b32 v252, 0x7fc12345\n\tv_mov_b32 v253, 0x7fc12345\n\tv_mov_b32 v254, 0x7fc12345\n\tv_mov_b32 v255, 0x7fc12345" ::: "v0","v1","v2","v3","v4","v5","v6","v7","v8","v9","v10","v11","v12","v13","v14","v15","v16","v17","v18","v19","v20","v21","v22","v23","v24","v25","v26","v27","v28","v29","v30","v31","v32","v33","v34","v35","v36","v37","v38","v39","v40","v41","v42","v43","v44","v45","v46","v47","v48","v49","v50","v51","v52","v53","v54","v55","v56","v57","v58","v59","v60","v61","v62","v63","v64","v65","v66","v67","v68","v69","v70","v71","v72","v73","v74","v75","v76","v77","v78","v79","v80","v81","v82","v83","v84","v85","v86","v87","v88","v89","v90","v91","v92","v93","v94","v95","v96","v97","v98","v99","v100","v101","v102","v103","v104","v105","v106","v107","v108","v109","v110","v111","v112","v113","v114","v115","v116","v117","v118","v119","v120","v121","v122","v123","v124","v125","v126","v127","v128","v129","v130","v131","v132","v133","v134","v135","v136","v137","v138","v139","v140","v141","v142","v143","v144","v145","v146","v147","v148","v149","v150","v151","v152","v153","v154","v155","v156","v157","v158","v159","v160","v161","v162","v163","v164","v165","v166","v167","v168","v169","v170","v171","v172","v173","v174","v175","v176","v177","v178","v179","v180","v181","v182","v183","v184","v185","v186","v187","v188","v189","v190","v191","v192","v193","v194","v195","v196","v197","v198","v199","v200","v201","v202","v203","v204","v205","v206","v207","v208","v209","v210","v211","v212","v213","v214","v215","v216","v217","v218","v219","v220","v221","v222","v223","v224","v225","v226","v227","v228","v229","v230","v231","v232","v233","v234","v235","v236","v237","v238","v239","v240","v241","v242","v243","v244","v245","v246","v247","v248","v249","v250","v251","v252","v253","v254","v255");
}
__global__ void __launch_bounds__(256) cmp2_kernel(const unsigned long long* cs, unsigned long long* prev, int nph, float* out, size_t nout) {
    __shared__ int sbad;
    if (threadIdx.x == 0) { int bad = -1; if (prev[0] == 0x1234567855aa33ccull) { for (int p = nph - 1; p >= 0; --p) if (cs[p] != prev[1 + p]) bad = p; } sbad = bad; }
    __syncthreads();
    const int bad = sbad;
    if (bad >= 0) { const float sc = 0.1f * (float)(bad + 1);
        for (size_t i = (size_t)blockIdx.x * 256 + threadIdx.x; i < nout; i += (size_t)gridDim.x * 256) out[i] += sc; }
}
__global__ void __launch_bounds__(64) store_prev_kernel(const unsigned long long* cs, unsigned long long* prev, int nph) {
    if (threadIdx.x < nph) prev[1 + threadIdx.x] = cs[threadIdx.x];
    if (threadIdx.x == 0) prev[0] = 0x1234567855aa33ccull;
}
__global__ void __launch_bounds__(256) cmp_kernel(const unsigned long long* cs, int nph, float* out, size_t nout) {
    int bad = -1; for (int p = nph - 1; p >= 0; --p) if (p == 0 && cs[0] != cs[1]) bad = 3;
    if (bad < 0) return; const float sc = 1.0f + 0.05f * (float)(bad + 1);
    for (size_t i = (size_t)blockIdx.x * 256 + threadIdx.x; i < nout; i += (size_t)gridDim.x * 256) out[i] *= sc;
}
#endif
extern "C" void kernel_launch(void* const* d_in, const int* in_sizes, int n_in, void* d_out, int out_size, void* d_ws, size_t ws_size, hipStream_t stream) {
    static int grid = 0;
    if (grid == 0) {
        if (n_in != 21 || out_size != NTOK * DMOD || ws_size < WS_END) { fprintf(stderr, "kernel_launch: unexpected shapes (n_in %d, out %d, ws %zu < %zu)\n", n_in, out_size, ws_size, (size_t)WS_END); grid = -1; return; }
        int dev = 0, cus = 0, per_cu = 0;
        if (hipGetDevice(&dev) != hipSuccess || hipDeviceGetAttribute(&cus, hipDeviceAttributeMultiprocessorCount, dev) != hipSuccess) { grid = -1; return; }
        if (hipFuncSetAttribute((const void*)mk_fwd, hipFuncAttributeMaxDynamicSharedMemorySize, LDS_BYTES) != hipSuccess) { fprintf(stderr, "kernel_launch: hipFuncSetAttribute failed\n"); grid = -1; return; }
        if (hipOccupancyMaxActiveBlocksPerMultiprocessor(&per_cu, (const void*)mk_fwd, 512, LDS_BYTES) != hipSuccess || per_cu < 1) fprintf(stderr, "kernel_launch: occupancy query says %d\n", per_cu);
        (void)hipGetLastError();
        grid = cus < 256 ? cus : 256;
    }
    if (grid < 0) return;
#ifdef MK_DBL
    (void)hipMemsetAsync((char*)d_ws, 0, WS_END, stream); (void)hipMemsetAsync(d_out, 0, (size_t)out_size * 4, stream);
#endif
    (void)hipMemsetAsync((char*)d_ws + WS_CTL, 0, 1 * MiB, stream);
    (void)hipMemsetAsync((char*)d_ws + WS_FF, 0xFF, 1 * MiB, stream);
    Args a{};
    for (int i = 0; i < 21; ++i) a.in[i] = (const float*)d_in[i];
    a.out = (float*)d_out; a.ws = (unsigned char*)d_ws;
#ifndef MK_CUTS
    a.ph_lo = 0; a.ph_hi = PH_TOTAL;
    hipLaunchKernelGGL(mk_fwd, dim3(grid), dim3(512), LDS_BYTES, stream, a);
#else
#ifdef MK_DBL
    unsigned long long* cs = (unsigned long long*)((char*)d_ws + 65536);
    unsigned long long* prev = (unsigned long long*)((char*)d_ws + WS_END + MiB);
    for (int p = 0; p < 5; ++p) { a.ph_lo = p; a.ph_hi = p + 1; hipLaunchKernelGGL(mk_fwd, dim3(grid), dim3(512), LDS_BYTES, stream, a); }
    hipLaunchKernelGGL(cs_kernel, dim3(2048), dim3(256), 0, stream, (const unsigned*)((char*)d_ws + WS_YA), (size_t)(16 * MiB / 4), (const unsigned*)d_out, (size_t)0, cs + 0);
    hipLaunchKernelGGL(cs_kernel, dim3(2048), dim3(256), 0, stream, (const unsigned*)((char*)d_ws + WS_YB), (size_t)(16 * MiB / 4), (const unsigned*)d_out, (size_t)0, cs + 1);
    hipLaunchKernelGGL(cs_kernel, dim3(2048), dim3(256), 0, stream, (const unsigned*)((char*)d_ws + WS_GATE), (size_t)(96 * MiB / 4), (const unsigned*)d_out, (size_t)0, cs + 2);
    for (int p = 5; p < PH_TOTAL; ++p) { a.ph_lo = p; a.ph_hi = p + 1; hipLaunchKernelGGL(mk_fwd, dim3(grid), dim3(512), LDS_BYTES, stream, a); }
    hipLaunchKernelGGL(cmp2_kernel, dim3(1024), dim3(256), 0, stream, (const unsigned long long*)cs, prev, 3, (float*)d_out, (size_t)out_size);
    hipLaunchKernelGGL(store_prev_kernel, dim3(1), dim3(64), 0, stream, (const unsigned long long*)cs, prev, 3);
#else

    for (int p = 0; p < PH_TOTAL; ++p) { a.ph_lo = p; a.ph_hi = p + 1; hipLaunchKernelGGL(mk_fwd, dim3(grid), dim3(512), LDS_BYTES, stream, a); }
#endif
#endif
}
```
